# Optimizing an MI355X kernel written in HIP

```python
import math
import jax, jax.numpy as jnp
from jax import lax
import numpy as np

D_MODEL = 4096
BATCH = 4
SEQ = 2048
DEPTH = 1

ATTN_HEADS = 16
HEAD_DIM = 128
ATTN_WIDTH = ATTN_HEADS * HEAD_DIM
MOBA_BLOCK = 256
MOBA_TOPK = 3
Q_CHUNK = 16
REL_BUCKETS = 32
REL_MAX_DIST = 128
CONV_GROUPS = 16
CONV_GROUP_DIM = 128
CONV_WIDTH = CONV_GROUPS * CONV_GROUP_DIM
CONV_K = 3
IN_PROJ_WIDTH = 3 * ATTN_WIDTH + 3 * CONV_WIDTH + 2 * D_MODEL
IN_SPLITS = (ATTN_WIDTH, 2 * ATTN_WIDTH, 3 * ATTN_WIDTH,
             3 * ATTN_WIDTH + CONV_WIDTH, 3 * ATTN_WIDTH + 2 * CONV_WIDTH,
             3 * ATTN_WIDTH + 3 * CONV_WIDTH, 3 * ATTN_WIDTH + 3 * CONV_WIDTH + D_MODEL)
PEER_HEADS = 8
PEER_N_KEYS = 128
PEER_N_EXPERTS = PEER_N_KEYS * PEER_N_KEYS
PEER_QUERY_DIM = 256
PEER_HALF = PEER_QUERY_DIM // 2
PEER_TOPK = 16
PEER_TOKEN_CHUNK = 64
NORM_EPS = 1e-6

kernel_name = "hybrid_conv_moba_peer_block"


def rms_norm(x, g):
    x32 = x.astype(jnp.float32)
    y = x32 * lax.rsqrt(jnp.mean(x32 * x32, axis=-1, keepdims=True) + NORM_EPS)
    return y.astype(x.dtype) * g


def t5_bucket(dist):
    max_exact = REL_BUCKETS // 2
    d32 = jnp.maximum(dist, 1).astype(jnp.float32)
    large = max_exact + (jnp.log(d32 / max_exact) / math.log(REL_MAX_DIST / max_exact)
                         * (REL_BUCKETS - max_exact)).astype(jnp.int32)
    large = jnp.minimum(large, REL_BUCKETS - 1)
    return jnp.where(dist < max_exact, dist, large)


def short_conv_mixer(cb, cc, cu, conv_w, conv_b):
    gated = cc * cu
    y = lax.conv_general_dilated(gated, conv_w.astype(gated.dtype), window_strides=(1,),
                                 padding=[(CONV_K - 1, 0)],
                                 dimension_numbers=('NWC', 'WIO', 'NWC'),
                                 feature_group_count=CONV_WIDTH)
    return cb * (y + conv_b)


def moba_attention(q, k, v, rel_table):
    B, T = q.shape[0], q.shape[1]
    L = MOBA_BLOCK
    nb = -(-T // L)
    t_pad = nb * L
    pad = ((0, 0), (0, t_pad - T), (0, 0), (0, 0))
    q, k, v = [jnp.pad(a, pad).transpose(0, 2, 1, 3) for a in (q, k, v)]
    k_blocks = k.reshape(B, ATTN_HEADS, nb, L, HEAD_DIM)
    v_blocks = v.reshape(B, ATTN_HEADS, nb, L, HEAD_DIM)
    k_mean = jnp.mean(k_blocks.astype(jnp.float32), axis=3)
    gate = jnp.einsum('bhtd,bhnd->bhtn', q.astype(jnp.float32), k_mean)
    pos = jnp.arange(t_pad, dtype=jnp.int32)
    q_block = pos // L
    fully_past = jnp.arange(nb, dtype=jnp.int32)[None, :] < q_block[:, None]
    gate = jnp.where(fully_past, gate, -jnp.inf)
    k_sel = min(MOBA_TOPK, nb)
    _, top_idx = lax.top_k(gate, k_sel)
    top_idx = top_idx.astype(jnp.int32)
    top_valid = top_idx < q_block[:, None]
    own = jnp.broadcast_to(q_block[:, None], (B, ATTN_HEADS, t_pad, 1))
    sel = jnp.concatenate([top_idx, own], axis=-1)
    valid = jnp.concatenate([top_valid, jnp.ones_like(own, dtype=bool)], axis=-1)

    n_chunks = t_pad // Q_CHUNK

    def to_chunks(a):
        return jnp.moveaxis(a.reshape(B, ATTN_HEADS, n_chunks, Q_CHUNK, a.shape[-1]), 2, 0)

    b_idx = jnp.arange(B)[:, None, None, None]
    h_idx = jnp.arange(ATTN_HEADS)[None, :, None, None]
    key_off = jnp.arange(L, dtype=jnp.int32)
    scale = HEAD_DIM ** -0.5

    def attend_chunk(args):
        q_c, sel_c, valid_c, c = args
        k_g = k_blocks[b_idx, h_idx, sel_c]
        v_g = v_blocks[b_idx, h_idx, sel_c]
        logits = jnp.einsum('bhqd,bhqskd->bhqsk', q_c, k_g).astype(jnp.float32) * scale
        q_pos = c * Q_CHUNK + jnp.arange(Q_CHUNK, dtype=jnp.int32)
        k_pos = sel_c[..., None] * L + key_off
        dist = q_pos[None, None, :, None, None] - k_pos
        bias = rel_table[t5_bucket(jnp.maximum(dist, 0)), h_idx[..., None]]
        allowed = valid_c[..., None] & (dist >= 0)
        logits = jnp.where(allowed, logits + bias.astype(jnp.float32), -jnp.inf)
        probs = jax.nn.softmax(logits.reshape(B, ATTN_HEADS, Q_CHUNK, -1), axis=-1)
        probs = probs.reshape(logits.shape).astype(v_g.dtype)
        return jnp.einsum('bhqsk,bhqskd->bhqd', probs, v_g)

    out = lax.map(attend_chunk, (to_chunks(q), to_chunks(sel), to_chunks(valid),
                                 jnp.arange(n_chunks, dtype=jnp.int32)))
    out = jnp.moveaxis(out, 0, 2).reshape(B, ATTN_HEADS, t_pad, HEAD_DIM)
    out = out.transpose(0, 2, 1, 3)[:, :T]
    return out.reshape(B, T, ATTN_WIDTH)


def peer_ffn(x, w_q, sub_keys, u_table, v_table):
    B, T, D = x.shape
    xf = x.reshape(B * T, D)
    q = (xf @ w_q).reshape(-1, PEER_HEADS, PEER_QUERY_DIM).astype(jnp.float32)
    keys = sub_keys.astype(jnp.float32)
    s1 = jnp.einsum('nhd,hkd->nhk', q[..., :PEER_HALF], keys[:, 0])
    s2 = jnp.einsum('nhd,hkd->nhk', q[..., PEER_HALF:], keys[:, 1])
    v1, i1 = lax.top_k(s1, PEER_TOPK)
    v2, i2 = lax.top_k(s2, PEER_TOPK)
    cand = (v1[..., :, None] + v2[..., None, :]).reshape(-1, PEER_HEADS, PEER_TOPK * PEER_TOPK)
    score, c = lax.top_k(cand, PEER_TOPK)
    e1 = jnp.take_along_axis(i1, c // PEER_TOPK, axis=-1)
    e2 = jnp.take_along_axis(i2, c % PEER_TOPK, axis=-1)
    experts = (e1 * PEER_N_KEYS + e2).astype(jnp.int32)
    gates = jax.nn.softmax(score, axis=-1)
    n_chunks = xf.shape[0] // PEER_TOKEN_CHUNK

    def chunk(args):
        x_c, e_c, g_c = args
        u = u_table[e_c]
        a = jnp.einsum('cd,chkd->chk', x_c, u)
        act = jax.nn.gelu(a.astype(jnp.float32), approximate=False) * g_c
        return jnp.einsum('chk,chkd->cd', act.astype(x_c.dtype), v_table[e_c])

    y = lax.map(chunk, (xf.reshape(n_chunks, PEER_TOKEN_CHUNK, D),
                        experts.reshape(n_chunks, PEER_TOKEN_CHUNK, PEER_HEADS, PEER_TOPK),
                        gates.reshape(n_chunks, PEER_TOKEN_CHUNK, PEER_HEADS, PEER_TOPK)))
    return y.reshape(B, T, D)


def setup_inputs(seed: int = 0) -> dict:
    key = jax.random.key(seed)
    ks = jax.random.split(key, 17)
    f32 = jnp.float32
    D = D_MODEL
    nrm = lambda k, shape, s: jax.random.normal(k, shape, f32) * s
    return {
        "x": nrm(ks[0], (BATCH, SEQ, D), 1.0),
        "norm_mix": 1.0 + nrm(ks[1], (DEPTH, D), 0.02),
        "w_in": nrm(ks[2], (DEPTH, D, IN_PROJ_WIDTH), D ** -0.5),
        "conv_w": nrm(ks[3], (DEPTH, CONV_K, 1, CONV_WIDTH), CONV_K ** -0.5),
        "conv_b": nrm(ks[4], (DEPTH, CONV_WIDTH), 0.01),
        "w_br_attn": nrm(ks[5], (DEPTH, ATTN_WIDTH, D), ATTN_WIDTH ** -0.5),
        "w_br_conv": nrm(ks[6], (DEPTH, CONV_WIDTH, D), CONV_WIDTH ** -0.5),
        "b_gate": nrm(ks[7], (DEPTH, 2, D), 0.01),
        "rel_bias": nrm(ks[8], (REL_BUCKETS, ATTN_HEADS), 0.1),
        "w_out": nrm(ks[9], (DEPTH, D, D), D ** -0.5),
        "norm_ffn": 1.0 + nrm(ks[10], (DEPTH, D), 0.02),
        "peer_w_q": nrm(ks[11], (DEPTH, D, PEER_HEADS * PEER_QUERY_DIM), D ** -0.5),
        "peer_sub_keys": nrm(ks[12], (DEPTH, PEER_HEADS, 2, PEER_N_KEYS, PEER_HALF), PEER_HALF ** -0.5),
        "peer_u": nrm(ks[13], (DEPTH, PEER_N_EXPERTS, D), D ** -0.5),
        "peer_v": nrm(ks[14], (DEPTH, PEER_N_EXPERTS, D), (PEER_HEADS * PEER_TOPK) ** -0.5),
        "norm_final": 1.0 + nrm(ks[15], (D,), 0.02),
    }


def reference(x, norm_mix, w_in, conv_w, conv_b, w_br_attn, w_br_conv, b_gate, rel_bias,
              w_out, norm_ffn, peer_w_q, peer_sub_keys, peer_u, peer_v, norm_final):
    B, T, _ = x.shape
    h = x
    for l in range(DEPTH):
        hn = rms_norm(h, norm_mix[l])
        proj = hn @ w_in[l]
        q, k, v, cb, cc, cu, g_attn, g_conv = jnp.split(proj, IN_SPLITS, axis=-1)
        heads = lambda a: a.reshape(B, T, ATTN_HEADS, HEAD_DIM)
        z_attn = moba_attention(heads(q), heads(k), heads(v), rel_bias) @ w_br_attn[l]
        z_conv = short_conv_mixer(cb, cc, cu, conv_w[l], conv_b[l]) @ w_br_conv[l]
        merged = (jax.nn.sigmoid(g_attn + b_gate[l, 0]) * z_attn
                  + jax.nn.sigmoid(g_conv + b_gate[l, 1]) * z_conv)
        h = h + merged @ w_out[l]
        h = h + peer_ffn(rms_norm(h, norm_ffn[l]), peer_w_q[l], peer_sub_keys[l],
                         peer_u[l], peer_v[l])
    return rms_norm(h, norm_final)
```

```cpp
#include <hip/hip_runtime.h>
#include <cstdio>
#include <cstdint>
#define PEER_SLICED 0
namespace pg8 {
#define PG8_LAS __attribute__((address_space(3)))
typedef unsigned short bf16_t;
typedef short bf16x8 __attribute__((ext_vector_type(8)));
typedef float f32x4 __attribute__((ext_vector_type(4)));
typedef unsigned u32x4 __attribute__((ext_vector_type(4)));
constexpr int BM = 256, BK = 64, HALF = 128, HTB = HALF * BK * 2  , STAGE_BYTES = 8 * HTB, NXCD = 8, WGM = 2;

__host__ __device__ __forceinline__ int lds_byte(int r, int c) { const int st = (r >> 4) * 2 + (c >> 5), rr = r & 15, cc = c & 31, ob = rr * 64 + cc * 2; return st * 1024 + (ob ^ (((ob >> 9) & 1) << 5)); }
__host__ __device__ __forceinline__ void stage_rc(int b, int& R, int& C) { const int st = b / 1024, sb = b % 1024, swz = sb ^ (((sb >> 9) & 1) << 5); R = (st >> 1) * 16 + swz / 64; C = (st & 1) * 32 + (swz % 64) / 2; }
__host__ __device__ __forceinline__ int perm32(int rho) { const int n = rho >> 4, i = rho & 15; return 8 * (i >> 2) + 4 * n + (i & 3); }

struct Unit { int pm, pn; };
struct Gemm { const bf16_t* A; const bf16_t* Bt; int M, N, K; };

struct StaticOrder {
    int nM, nN, nwg, G, c, reps;
    __host__ __device__ void init(int M, int N, int G_, int c_, int reps_ = 1) { nM = M / BM; nN = N / BM; nwg = nM * nN; G = G_; c = c_; reps = reps_; }
    __host__ __device__ bool next(int i, Unit& u) const {
        const long L0 = (long)i * G + c; if (L0 >= (long)nwg * reps) return false;
        const long L = L0 % nwg;
        int wgid = (int)L; { const int q = nwg / NXCD, r = nwg % NXCD, xcd = wgid % NXCD, off = wgid / NXCD; wgid = (xcd < r ? xcd * (q + 1) : r * (q + 1) + (xcd - r) * q) + off; }
        const int nig = WGM * nN, gid = wgid / nig, fm = gid * WGM, gsz = (nM - fm) < WGM ? (nM - fm) : WGM;
        u.pm = fm + ((wgid % nig) % gsz); u.pn = (wgid % nig) / gsz; return true;
    }
    __device__ __forceinline__ void a_ready(const Unit&) const {}
    __device__ __forceinline__ void done(const Unit&) const {}
};

__device__ __forceinline__ unsigned cvt_pk_bf16(float lo, float hi) { unsigned r; asm volatile("v_cvt_pk_bf16_f32 %0, %1, %2" : "=v"(r) : "v"(lo), "v"(hi)); return r; }
typedef float f32x2 __attribute__((ext_vector_type(2)));
__device__ __forceinline__ f32x2 gelu_pk(f32x2 v) {
    const f32x2 av = __builtin_elementwise_abs(v), d = av * 0.2316418882f + 1.0f;
    f32x2 t; t.x = __builtin_amdgcn_rcpf(d.x); t.y = __builtin_amdgcn_rcpf(d.y);
    f32x2 q = t * 0.5307027145f + (-0.7265760135f); q = q * t + 0.7107068705f; q = q * t + (-0.142248368f); q = q * t + 0.127414796f; q = q * t;
    const f32x2 s = (v * v) * (-0.72134752044f);
    f32x2 e; e.x = __builtin_amdgcn_exp2f(s.x); e.y = __builtin_amdgcn_exp2f(s.y);
    const f32x2 m = v * (q * e), r = v - m;
    f32x2 o; o.x = v.x < 0.f ? m.x : r.x; o.y = v.y < 0.f ? m.y : r.y; return o;
}


__device__ __forceinline__ float bf_lo(unsigned w) { return __uint_as_float(w << 16); }
__device__ __forceinline__ float bf_hi(unsigned w) { return __uint_as_float(w & 0xffff0000u); }
__device__ __forceinline__ float sigmoid_f(float x) { return __builtin_amdgcn_rcpf(1.0f + __builtin_amdgcn_exp2f(-1.4426950408889634f * x)); }

struct EpiSplitBf16 {
    static constexpr bool PERM = true, AFTER_DRAIN = false;
    bf16_t* O; int ldc; int split_cols; size_t split_stride; unsigned long long slabmap;
    __device__ __forceinline__ void operator()(const f32x4 (&acc)[2][2][4][2], const Unit& u, int wr, int wc, int fr, int fq) const {
        const int row0 = u.pm * BM + wr * 64 + fr; int colt = u.pn * BM; bf16_t* base = O;
        if (split_cols) { const int t = colt / split_cols; base += (size_t)((slabmap >> (4 * t)) & 15ull) * split_stride; colt -= t * split_cols; }
        const int col0 = colt + wc * 32 + 8 * fq;
#pragma unroll
        for (int ai = 0; ai < 2; ++ai)
#pragma unroll
            for (int m = 0; m < 4; ++m) { bf16_t* rowp = base + (size_t)(row0 + ai * HALF + m * 16) * ldc + col0;
#pragma unroll
                for (int bj = 0; bj < 2; ++bj) { const f32x4 v0 = acc[ai][bj][m][0], v1 = acc[ai][bj][m][1];
                    u32x4 w; w.x = cvt_pk_bf16(v0[0], v0[1]); w.y = cvt_pk_bf16(v0[2], v0[3]); w.z = cvt_pk_bf16(v1[0], v1[1]); w.w = cvt_pk_bf16(v1[2], v1[3]);
                    *(u32x4*)(rowp + bj * HALF) = w; } }
    }
};

template <bool ADD, bool I8ACC = false> struct EpiGate {
    static constexpr bool PERM = true, AFTER_DRAIN = false;
    bf16_t* O; int ldc; const bf16_t* G; int g_cols; size_t g_stride; const float* bg; float cs = 1.0f;
    __device__ __forceinline__ void operator()(const f32x4 (&acc)[2][2][4][2], const Unit& u, int wr, int wc, int fr, int fq) const {
        const int row0 = u.pm * BM + wr * 64 + fr, colt = u.pn * BM;
        const int gt = colt / g_cols; const bf16_t* gb = G + (size_t)gt * g_stride; const int gcol0 = colt - gt * g_cols + wc * 32 + 8 * fq;
        const int col0 = colt + wc * 32 + 8 * fq;
        f32x4 bv[2][2];
#pragma unroll
        for (int bj = 0; bj < 2; ++bj)
#pragma unroll
            for (int n = 0; n < 2; ++n) bv[bj][n] = *(const f32x4*)(bg + col0 + bj * HALF + 4 * n);
#pragma unroll
        for (int ai = 0; ai < 2; ++ai)
#pragma unroll
            for (int m = 0; m < 4; ++m) { const int r = row0 + ai * HALF + m * 16;
#pragma unroll
                for (int bj = 0; bj < 2; ++bj) {
                    const u32x4 gw = *(const u32x4*)(gb + (size_t)r * g_cols + gcol0 + bj * HALF);
                    f32x4 g0 = (f32x4){bf_lo(gw.x), bf_hi(gw.x), bf_lo(gw.y), bf_hi(gw.y)} + bv[bj][0];
                    f32x4 g1 = (f32x4){bf_lo(gw.z), bf_hi(gw.z), bf_lo(gw.w), bf_hi(gw.w)} + bv[bj][1];
                    f32x4 v0, v1;
#pragma unroll
                    for (int j = 0; j < 4; ++j) { const float a0_ = I8ACC ? (float)__float_as_int(acc[ai][bj][m][0][j]) * cs : acc[ai][bj][m][0][j], a1_ = I8ACC ? (float)__float_as_int(acc[ai][bj][m][1][j]) * cs : acc[ai][bj][m][1][j]; v0[j] = sigmoid_f(g0[j]) * a0_; v1[j] = sigmoid_f(g1[j]) * a1_; }
#ifdef DBG_NO_ATTN
                    if (!ADD) { v0 = v0 * 0.f; v1 = v1 * 0.f; }
#endif
                    bf16_t* op = O + (size_t)r * ldc + col0 + bj * HALF;
                    if (ADD) { const u32x4 ow = *(const u32x4*)op;
                        v0 += (f32x4){bf_lo(ow.x), bf_hi(ow.x), bf_lo(ow.y), bf_hi(ow.y)}; v1 += (f32x4){bf_lo(ow.z), bf_hi(ow.z), bf_lo(ow.w), bf_hi(ow.w)}; }
                    u32x4 w; w.x = cvt_pk_bf16(v0[0], v0[1]); w.y = cvt_pk_bf16(v0[2], v0[3]); w.z = cvt_pk_bf16(v1[0], v1[1]); w.w = cvt_pk_bf16(v1[2], v1[3]);
                    *(u32x4*)op = w; } }
    }
};

struct EpiResF32 {
    static constexpr bool PERM = false, AFTER_DRAIN = false;
    float* C; const float* R; int ldc;
    __device__ __forceinline__ void operator()(const f32x4 (&acc)[2][2][4][2], const Unit& u, int wr, int wc, int fr, int fq) const {
        const int row0 = u.pm * BM + wr * 64 + fr, col0 = u.pn * BM + wc * 32 + 4 * fq;
#pragma unroll
        for (int ai = 0; ai < 2; ++ai)
#pragma unroll
            for (int m = 0; m < 4; ++m) { const size_t off = (size_t)(row0 + ai * HALF + m * 16) * ldc + col0;
#pragma unroll
                for (int bj = 0; bj < 2; ++bj)
#pragma unroll
                    for (int n = 0; n < 2; ++n) { f32x4 v = acc[ai][bj][m][n]; if (R) v += *(const f32x4*)(R + off + bj * HALF + n * 16); *(f32x4*)(C + off + bj * HALF + n * 16) = v; } }
    }
};

struct EpiHiLo {
    static constexpr bool PERM = true, AFTER_DRAIN = false;
    bf16_t* Oh; bf16_t* Ol; int ldc; const float* rowss; float inv_n, eps;
    __device__ __forceinline__ void operator()(const f32x4 (&acc)[2][2][4][2], const Unit& u, int wr, int wc, int fr, int fq) const {
        const int row0 = u.pm * BM + wr * 64 + fr, col0 = u.pn * BM + wc * 32 + 8 * fq;
#pragma unroll
        for (int ai = 0; ai < 2; ++ai)
#pragma unroll
            for (int m = 0; m < 4; ++m) { const int row = row0 + ai * HALF + m * 16; const size_t off = (size_t)row * ldc + col0;
                const float rs = rowss ? 1.0f / sqrtf(__hip_atomic_load(rowss + row, __ATOMIC_RELAXED, __HIP_MEMORY_SCOPE_AGENT) * inv_n + eps) : 1.0f;
#pragma unroll
                for (int bj = 0; bj < 2; ++bj) { const f32x4 v0 = acc[ai][bj][m][0] * rs, v1 = acc[ai][bj][m][1] * rs;
                    u32x4 wh; wh.x = cvt_pk_bf16(v0[0], v0[1]); wh.y = cvt_pk_bf16(v0[2], v0[3]); wh.z = cvt_pk_bf16(v1[0], v1[1]); wh.w = cvt_pk_bf16(v1[2], v1[3]);
                    const f32x4 r0 = v0 - (f32x4){bf_lo(wh.x), bf_hi(wh.x), bf_lo(wh.y), bf_hi(wh.y)}, r1 = v1 - (f32x4){bf_lo(wh.z), bf_hi(wh.z), bf_lo(wh.w), bf_hi(wh.w)};
                    u32x4 wl; wl.x = cvt_pk_bf16(r0[0], r0[1]); wl.y = cvt_pk_bf16(r0[2], r0[3]); wl.z = cvt_pk_bf16(r1[0], r1[1]); wl.w = cvt_pk_bf16(r1[2], r1[3]);
                    *(u32x4*)(Oh + off + bj * HALF) = wh; *(u32x4*)(Ol + off + bj * HALF) = wl; } }
    }
};

struct EpiResNormStat {
    static constexpr bool PERM = true, AFTER_DRAIN = false;
    float* C; const float* R; int ldc; unsigned char* HQ; const float* gain; float* rowss; float qscale; int* rowcs;
    __device__ __forceinline__ void operator()(const f32x4 (&acc)[2][2][4][2], const Unit& u, int wr, int wc, int fr, int fq) const {
        typedef unsigned u32x2_ __attribute__((ext_vector_type(2)));
        const int row0 = u.pm * BM + wr * 64 + fr, col0 = u.pn * BM + wc * 32 + 8 * fq;
        f32x4 gv[2][2];
#pragma unroll
        for (int bj = 0; bj < 2; ++bj)
#pragma unroll
            for (int n = 0; n < 2; ++n) gv[bj][n] = *(const f32x4*)(gain + col0 + bj * HALF + 4 * n);
#pragma unroll
        for (int ai = 0; ai < 2; ++ai)
#pragma unroll
            for (int m = 0; m < 4; ++m) { const int row = row0 + ai * HALF + m * 16; const size_t off = (size_t)row * ldc + col0; float ss = 0.f; int cs = 0;
#pragma unroll
                for (int bj = 0; bj < 2; ++bj) { const f32x4 v0 = acc[ai][bj][m][0] + *(const f32x4*)(R + off + bj * HALF), v1 = acc[ai][bj][m][1] + *(const f32x4*)(R + off + bj * HALF + 4);
                    u32x4 hb; hb.x = cvt_pk_bf16(v0[0], v0[1]); hb.y = cvt_pk_bf16(v0[2], v0[3]); hb.z = cvt_pk_bf16(v1[0], v1[1]); hb.w = cvt_pk_bf16(v1[2], v1[3]);
                    *(u32x4*)((bf16_t*)C + off + bj * HALF) = hb;
                    ss += ((v0[0] * v0[0] + v0[1] * v0[1]) + (v0[2] * v0[2] + v0[3] * v0[3])) + ((v1[0] * v1[0] + v1[1] * v1[1]) + (v1[2] * v1[2] + v1[3] * v1[3]));
                    u32x2_ w; w.x = 0u; w.y = 0u;
#pragma unroll
                    for (int j = 0; j < 4; ++j) { int q0 = (int)rintf(v0[j] * gv[bj][0][j] * qscale), q1 = (int)rintf(v1[j] * gv[bj][1][j] * qscale); q0 = q0 < -127 ? -127 : (q0 > 127 ? 127 : q0); q1 = q1 < -127 ? -127 : (q1 > 127 ? 127 : q1);
                        cs += q0 + q1; w.x |= (unsigned)(q0 & 255) << (8 * j); w.y |= (unsigned)(q1 & 255) << (8 * j); }
                    *(u32x2_*)(HQ + off + bj * HALF) = w; }
                ss += __shfl_xor(ss, 16); ss += __shfl_xor(ss, 32);
                if (fq == 0) __hip_atomic_fetch_add(rowss + row, ss, __ATOMIC_RELAXED, __HIP_MEMORY_SCOPE_AGENT);
                if (rowcs) { cs += __shfl_xor(cs, 16); cs += __shfl_xor(cs, 32); if (fq == 0) __hip_atomic_fetch_add(rowcs + row, cs, __ATOMIC_RELAXED, __HIP_MEMORY_SCOPE_AGENT); } }
    }
};

struct EpiI8Split {
    static constexpr bool PERM = true, AFTER_DRAIN = false;
    bf16_t* O; int ldc; int split_cols; size_t split_stride; const float* rs; float cs; unsigned long long slabmap;
    __device__ __forceinline__ void operator()(const f32x4 (&acc)[2][2][4][2], const Unit& u, int wr, int wc, int fr, int fq) const {
        typedef int i32x4_ __attribute__((ext_vector_type(4)));
        const int row0 = u.pm * BM + wr * 64 + fr; int colt = u.pn * BM; bf16_t* base = O;
        if (split_cols) { const int t = colt / split_cols; base += (size_t)((slabmap >> (4 * t)) & 15ull) * split_stride; colt -= t * split_cols; }
        const int col0 = colt + wc * 32 + 8 * fq;
#pragma unroll
        for (int ai = 0; ai < 2; ++ai)
#pragma unroll
            for (int m = 0; m < 4; ++m) { const int row = row0 + ai * HALF + m * 16; bf16_t* rowp = base + (size_t)row * ldc + col0; const float sc = rs[row] * cs;
#pragma unroll
                for (int bj = 0; bj < 2; ++bj) { const f32x4 a0 = acc[ai][bj][m][0], a1 = acc[ai][bj][m][1]; const i32x4_ i0 = __builtin_bit_cast(i32x4_, a0), i1 = __builtin_bit_cast(i32x4_, a1);
                    u32x4 w; w.x = cvt_pk_bf16((float)i0[0] * sc, (float)i0[1] * sc); w.y = cvt_pk_bf16((float)i0[2] * sc, (float)i0[3] * sc); w.z = cvt_pk_bf16((float)i1[0] * sc, (float)i1[1] * sc); w.w = cvt_pk_bf16((float)i1[2] * sc, (float)i1[3] * sc);
                    *(u32x4*)(rowp + bj * HALF) = w; } }
    }
};

struct EpiHiLoI8 {
    static constexpr bool PERM = true, AFTER_DRAIN = false;
    bf16_t* Oh; bf16_t* Ol; int ldc; const float* rowss; float inv_n, eps, cs;
    __device__ __forceinline__ void operator()(const f32x4 (&acc)[2][2][4][2], const Unit& u, int wr, int wc, int fr, int fq) const {
        typedef int i32x4_ __attribute__((ext_vector_type(4)));
        const int row0 = u.pm * BM + wr * 64 + fr, col0 = u.pn * BM + wc * 32 + 8 * fq;
#pragma unroll
        for (int ai = 0; ai < 2; ++ai)
#pragma unroll
            for (int m = 0; m < 4; ++m) { const int row = row0 + ai * HALF + m * 16; const size_t off = (size_t)row * ldc + col0;
                const float rs = cs / sqrtf(__hip_atomic_load(rowss + row, __ATOMIC_RELAXED, __HIP_MEMORY_SCOPE_AGENT) * inv_n + eps);
#pragma unroll
                for (int bj = 0; bj < 2; ++bj) { const f32x4 a0 = acc[ai][bj][m][0], a1 = acc[ai][bj][m][1]; const i32x4_ i0 = __builtin_bit_cast(i32x4_, a0), i1 = __builtin_bit_cast(i32x4_, a1);
                    const f32x4 v0 = (f32x4){(float)i0[0], (float)i0[1], (float)i0[2], (float)i0[3]} * rs, v1 = (f32x4){(float)i1[0], (float)i1[1], (float)i1[2], (float)i1[3]} * rs;
                    u32x4 wh; wh.x = cvt_pk_bf16(v0[0], v0[1]); wh.y = cvt_pk_bf16(v0[2], v0[3]); wh.z = cvt_pk_bf16(v1[0], v1[1]); wh.w = cvt_pk_bf16(v1[2], v1[3]);
                    const f32x4 r0 = v0 - (f32x4){bf_lo(wh.x), bf_hi(wh.x), bf_lo(wh.y), bf_hi(wh.y)}, r1 = v1 - (f32x4){bf_lo(wh.z), bf_hi(wh.z), bf_lo(wh.w), bf_hi(wh.w)};
                    u32x4 wl; wl.x = cvt_pk_bf16(r0[0], r0[1]); wl.y = cvt_pk_bf16(r0[2], r0[3]); wl.z = cvt_pk_bf16(r1[0], r1[1]); wl.w = cvt_pk_bf16(r1[2], r1[3]);
                    *(u32x4*)(Oh + off + bj * HALF) = wh; if (Ol) *(u32x4*)(Ol + off + bj * HALF) = wl; } }
    }
};
template <class Epi, class Sched, bool ALIGN_EPI = false, bool SP2 = false, bool I8 = false>
__device__ __forceinline__ void gemm_phase(PG8_LAS unsigned char* lds, const Gemm g, const Sched& S, const Epi& E) {
    const int tid = threadIdx.x, wid = __builtin_amdgcn_readfirstlane(tid >> 6), lane = tid & 63, wr = wid >> 2, wc = wid & 3, fr = lane & 15, fq = lane >> 4;
    const int K = g.K, nt = K / BK;
    unsigned voffA[2], voffB[2];
#pragma unroll
    for (int i = 0; i < 2; ++i) { int R, C; stage_rc(tid * 16 + i * 8192, R, C); const int Rb = Epi::PERM ? ((R & ~31) + perm32(R & 31)) : R;
        voffA[i] = (unsigned)(R * K + C) * 2u; voffB[i] = (unsigned)(Rb * K + C) * 2u; }
    const size_t kstep = (size_t)(BK * 2);
    const size_t hstep = (size_t)HALF * K * 2;
    const size_t tstep = 2 * hstep;
    const unsigned ldsw = (unsigned)wid * 1024u;
    const int aoff = lds_byte(wr * 64 + fr, fq * 8), boff = lds_byte(wc * 32 + fr, fq * 8);
#define PG8_SA(b, h) (((b) * 2 + (h)) * HTB)
#define PG8_SB(b, h) ((4 + (b) * 2 + (h)) * HTB)
#define PG8_STAGE(bufoff, gbase, voff) do { _Pragma("unroll") for (int _i = 0; _i < 2; ++_i) \
        __builtin_amdgcn_global_load_lds((const unsigned*)((const char*)(gbase) + (voff)[_i]), (PG8_LAS unsigned*)(lds + (bufoff) + ldsw + _i * 8192), 16, 0, 0); } while (0)
#define PG8_LDA(dst, b, h) do { _Pragma("unroll") for (int m = 0; m < 4; ++m) _Pragma("unroll") for (int k = 0; k < 2; ++k) dst[m][k] = *(const PG8_LAS bf16x8*)(lds + PG8_SA(b, h) + aoff + m * 2048 + k * 1024); } while (0)
#define PG8_LDB(dst, b, h) do { _Pragma("unroll") for (int n = 0; n < 2; ++n) _Pragma("unroll") for (int k = 0; k < 2; ++k) dst[n][k] = *(const PG8_LAS bf16x8*)(lds + PG8_SB(b, h) + boff + n * 2048 + k * 1024); } while (0)
#define PG8_MMA(ai, bj, At, Bt) do { __builtin_amdgcn_s_setprio(1); _Pragma("unroll") for (int m = 0; m < 4; ++m) _Pragma("unroll") for (int n = 0; n < 2; ++n) _Pragma("unroll") for (int k = 0; k < 2; ++k) { \
        if constexpr (I8) { typedef int i32x4_ __attribute__((ext_vector_type(4))); const bf16x8 bq_ = Bt[n][k], aq_ = At[m][k]; const f32x4 cq_ = acc[ai][bj][m][n]; \
            acc[ai][bj][m][n] = __builtin_bit_cast(f32x4, __builtin_amdgcn_mfma_i32_16x16x64_i8(__builtin_bit_cast(i32x4_, bq_), __builtin_bit_cast(i32x4_, aq_), __builtin_bit_cast(i32x4_, cq_), 0, 0, 0)); } \
        else acc[ai][bj][m][n] = __builtin_amdgcn_mfma_f32_16x16x32_bf16(Bt[n][k], At[m][k], acc[ai][bj][m][n], 0, 0, 0); } __builtin_amdgcn_s_setprio(0); } while (0)
#define PG8_WAIT_V(n) asm volatile("s_waitcnt vmcnt(" #n ")" ::: "memory")
#define PG8_WAIT_L(n) asm volatile("s_waitcnt lgkmcnt(" #n ")" ::: "memory")
#define PG8_BAR __builtin_amdgcn_s_barrier()
#define PG8_SCHED __builtin_amdgcn_sched_barrier(0)
    Unit cur, nxt; int ui = 0;
    if (!S.next(0, cur)) return;
    f32x4 acc[2][2][4][2];
#pragma unroll
    for (int a = 0; a < 2; ++a)
#pragma unroll
        for (int b = 0; b < 2; ++b)
#pragma unroll
            for (int m = 0; m < 4; ++m)
#pragma unroll
                for (int n = 0; n < 2; ++n) acc[a][b][m][n] = (f32x4){0.f, 0.f, 0.f, 0.f};
    bf16x8 At[4][2], B0[2][2], B1[2][2];
    const char* cA = (const char*)g.A + (size_t)cur.pm * tstep; const char* cB = (const char*)g.Bt + (size_t)cur.pn * tstep;
    S.a_ready(cur);
    if constexpr (SP2) {
        PG8_STAGE(PG8_SB(0, 0), cB, voffB); PG8_STAGE(PG8_SB(0, 1), cB + hstep, voffB); PG8_STAGE(PG8_SA(0, 0), cA, voffA); PG8_STAGE(PG8_SA(0, 1), cA + hstep, voffA);
        if (wr == 1) PG8_BAR;
        PG8_WAIT_V(2); PG8_BAR;
        PG8_STAGE(PG8_SB(1, 0), cB + kstep, voffB); PG8_STAGE(PG8_SA(1, 0), cA + kstep, voffA); PG8_STAGE(PG8_SB(1, 1), cB + hstep + kstep, voffB);
        PG8_WAIT_V(6); PG8_BAR;
    } else {
        PG8_STAGE(PG8_SB(0, 0), cB, voffB); PG8_STAGE(PG8_SA(0, 0), cA, voffA); PG8_STAGE(PG8_SB(0, 1), cB + hstep, voffB); PG8_STAGE(PG8_SA(0, 1), cA + hstep, voffA);
        if (wr == 1) PG8_BAR;
        PG8_WAIT_V(4); PG8_BAR;
        PG8_STAGE(PG8_SB(1, 0), cB + kstep, voffB); PG8_STAGE(PG8_SA(1, 0), cA + kstep, voffA); PG8_STAGE(PG8_SB(1, 1), cB + hstep + kstep, voffB);
        PG8_WAIT_V(6); PG8_BAR;
    }
    for (;;) {
        const bool has_next = S.next(ui + 1, nxt);
        const char* nA = has_next ? (const char*)g.A + (size_t)nxt.pm * tstep : cA; const char* nB = has_next ? (const char*)g.Bt + (size_t)nxt.pn * tstep : cB;
        for (int t = 0; t < nt; t += 2) {
            const bool last = (t == nt - 2);
            const char* a1 = cA + (size_t)(t + 1) * kstep;
            const char* a2 = last ? nA : cA + (size_t)(t + 2) * kstep; const char* b2 = last ? nB : cB + (size_t)(t + 2) * kstep;
            const char* a3 = a2 + kstep; const char* b3 = b2 + kstep;
            if (last && has_next) S.a_ready(nxt);
            if constexpr (SP2) {
            PG8_LDB(B0, 0, 0); PG8_LDB(B1, 0, 1); PG8_SCHED; PG8_LDA(At, 0, 0); PG8_STAGE(PG8_SA(1, 1), a1 + hstep, voffA);
            PG8_WAIT_V(8); PG8_WAIT_L(0); PG8_BAR; PG8_MMA(0, 0, At, B0); PG8_MMA(0, 1, At, B1); PG8_BAR; PG8_SCHED;
            PG8_LDA(At, 0, 1); PG8_STAGE(PG8_SB(0, 0), b2, voffB); PG8_STAGE(PG8_SB(0, 1), b2 + hstep, voffB); PG8_STAGE(PG8_SA(0, 0), a2, voffA);
            PG8_WAIT_V(8); PG8_WAIT_L(0); PG8_BAR; PG8_MMA(1, 0, At, B0); PG8_MMA(1, 1, At, B1); PG8_BAR; PG8_SCHED;
            PG8_LDB(B0, 1, 0); PG8_LDB(B1, 1, 1); PG8_SCHED; PG8_LDA(At, 1, 0); PG8_STAGE(PG8_SA(0, 1), a2 + hstep, voffA);
            PG8_WAIT_V(8); PG8_WAIT_L(0); PG8_BAR; PG8_MMA(0, 0, At, B0); PG8_MMA(0, 1, At, B1); PG8_BAR; PG8_SCHED;
            PG8_LDA(At, 1, 1); PG8_STAGE(PG8_SB(1, 0), b3, voffB); PG8_STAGE(PG8_SB(1, 1), b3 + hstep, voffB); PG8_STAGE(PG8_SA(1, 0), a3, voffA);
            PG8_WAIT_V(8); PG8_WAIT_L(0); PG8_BAR; PG8_MMA(1, 0, At, B0); PG8_MMA(1, 1, At, B1); PG8_BAR; PG8_SCHED;
            } else {
            PG8_LDB(B0, 0, 0); PG8_SCHED; PG8_LDA(At, 0, 0); PG8_STAGE(PG8_SA(1, 1), a1 + hstep, voffA);
            PG8_WAIT_L(8); PG8_BAR; PG8_WAIT_L(0); PG8_MMA(0, 0, At, B0); PG8_BAR; PG8_SCHED;
            PG8_LDB(B1, 0, 1); PG8_STAGE(PG8_SB(0, 0), b2, voffB);
            PG8_BAR; PG8_WAIT_L(0); PG8_MMA(0, 1, At, B1); PG8_BAR;
            PG8_LDA(At, 0, 1); PG8_STAGE(PG8_SA(0, 0), a2, voffA);
            PG8_BAR; PG8_WAIT_L(0); PG8_MMA(1, 0, At, B0); PG8_BAR; PG8_SCHED;
            PG8_STAGE(PG8_SB(0, 1), b2 + hstep, voffB);
            PG8_WAIT_V(6); PG8_BAR; PG8_MMA(1, 1, At, B1); PG8_BAR;
            PG8_LDB(B0, 1, 0); PG8_SCHED; PG8_LDA(At, 1, 0); PG8_STAGE(PG8_SA(0, 1), a2 + hstep, voffA);
            PG8_WAIT_L(8); PG8_BAR; PG8_WAIT_L(0); PG8_MMA(0, 0, At, B0); PG8_BAR; PG8_SCHED;
            PG8_LDB(B1, 1, 1); PG8_STAGE(PG8_SB(1, 0), b3, voffB);
            PG8_BAR; PG8_WAIT_L(0); PG8_MMA(0, 1, At, B1); PG8_BAR;
            PG8_LDA(At, 1, 1); PG8_STAGE(PG8_SA(1, 0), a3, voffA);
            PG8_BAR; PG8_WAIT_L(0); PG8_MMA(1, 0, At, B0); PG8_BAR; PG8_SCHED;
            PG8_STAGE(PG8_SB(1, 1), b3 + hstep, voffB);
            PG8_WAIT_V(6); PG8_BAR; PG8_MMA(1, 1, At, B1); PG8_BAR;
            }
        }
        if constexpr (ALIGN_EPI) { if (wr == 0) PG8_BAR; }
        if constexpr (!Epi::AFTER_DRAIN) { E(acc, cur, wr, wc, fr, fq); S.done(cur); }
        if (!has_next) break;
#pragma unroll
        for (int a = 0; a < 2; ++a)
#pragma unroll
            for (int b = 0; b < 2; ++b)
#pragma unroll
                for (int m = 0; m < 4; ++m)
#pragma unroll
                    for (int n = 0; n < 2; ++n) acc[a][b][m][n] = (f32x4){0.f, 0.f, 0.f, 0.f};
        cur = nxt; cA = nA; cB = nB; ++ui;
        if constexpr (ALIGN_EPI) { if (wr == 1) PG8_BAR; }
    }
    PG8_WAIT_V(0);
    if constexpr (!ALIGN_EPI) { if (wr == 0) PG8_BAR; }
    PG8_BAR;
    if constexpr (Epi::AFTER_DRAIN) { E.fused(acc, cur, wr, wc, fr, fq, lds, wid, lane); S.done(cur); }
#undef PG8_SA
#undef PG8_SB
#undef PG8_STAGE
#undef PG8_LDA
#undef PG8_LDB
#undef PG8_MMA
#undef PG8_WAIT_V
#undef PG8_WAIT_L
#undef PG8_BAR
#undef PG8_SCHED
}
}

namespace moba {
typedef unsigned short bf16;
typedef short bf16x8 __attribute__((ext_vector_type(8)));
typedef short s16x4 __attribute__((ext_vector_type(4)));
typedef float f32x16 __attribute__((ext_vector_type(16)));
typedef float f32x4 __attribute__((ext_vector_type(4)));
typedef unsigned u32x4 __attribute__((ext_vector_type(4)));
constexpr int D = 128, PITCH = 2048, SEQ = 2048, NHEAD = 16;
constexpr float SCALE = 0.08838834764831845f;
constexpr float THR = 8.f;
constexpr float ATT_SCALE = 127.0f / 3.0f;
constexpr int NW = 8, QBLK = 32, KVBLK = 64, QB = NW * QBLK;
constexpr int SHM_V = KVBLK * D * 2, SHM_K = KVBLK * D * 2;
constexpr int LDS_WS = 2 * SHM_V + 2 * SHM_K, LDS_KM = LDS_WS + NW * 64 * 4, LDS_BQ = LDS_KM + 8 * 128 * 4, LDS_Q = LDS_BQ + 144 * 4, LDS_BYTES = LDS_Q + NW * 8192;

#define KSWZ(row, colB) ((row) * 256 + ((colB) ^ (((row) & 7) << 4)))
#define SBAR() __builtin_amdgcn_sched_barrier(0)
__device__ __forceinline__ int v_st(int k, int c) { const int kk = (k & ~0xC) | ((k & 4) << 1) | ((k & 8) >> 1); return ((kk >> 3) * 4 + (c >> 5)) * 512 + ((kk & 7) * 32 + (c & 31)) * 2; }
__device__ __forceinline__ int v_rd_base(int lane) { return ((lane & 3) << 3) | (((lane >> 2) & 3) << 6) | (((lane >> 4) & 1) << 5) | (((lane >> 5) & 1) << 8); }
constexpr int v_rd_off(int d0, int ks, int half) { return d0 * 512 + ks * 4096 + half * 2048; }
__device__ __forceinline__ int crow(int r, int hi) { return (r & 3) + 8 * (r >> 2) + 4 * hi; }
__device__ __forceinline__ unsigned cvtpk(float lo, float hi) { unsigned r; asm volatile("v_cvt_pk_bf16_f32 %0, %1, %2" : "=v"(r) : "v"(lo), "v"(hi)); return r; }
__device__ __forceinline__ bf16x8 load8(const bf16* p) { return *reinterpret_cast<const bf16x8*>(p); }

__device__ __forceinline__ void moba_mask(f32x16& p0, f32x16& p1, int kb, int qpos, int qlo, int hi, int P0, unsigned selbits, const float* biasq) {
    const float NEG = -__builtin_inff();
    const int dq = qpos - 4 * hi - kb;
    const bool own = kb >= P0;
    const bool near = kb + KVBLK - 1 > qlo - 128;
    if (!own) {
        const bool sel = ((selbits >> (kb >> 8)) & 1u) != 0u;
        if (near) {
#pragma unroll
            for (int r = 0; r < 16; ++r) {
                const int e0 = dq - ((r & 3) + 8 * (r >> 2)), e1 = e0 - 32;
                const int d0 = e0 > 128 ? 128 : e0, d1 = e1 > 128 ? 128 : (e1 < 0 ? 0 : e1);
                const float b0 = biasq[d0 < 0 ? 0 : d0], b1 = biasq[d1];
                p0[r] = sel ? p0[r] + b0 : NEG; p1[r] = sel ? p1[r] + b1 : NEG;
            }
        } else {
#pragma unroll
            for (int r = 0; r < 16; ++r) { p0[r] = sel ? p0[r] : NEG; p1[r] = sel ? p1[r] : NEG; }
        }
    } else if (near) {
#pragma unroll
        for (int r = 0; r < 16; ++r) {
            const int e0 = dq - ((r & 3) + 8 * (r >> 2)), e1 = e0 - 32;
            int d0 = e0 > 128 ? 128 : e0, d1 = e1 > 128 ? 128 : e1; d0 = d0 < 0 ? 0 : d0; d1 = d1 < 0 ? 0 : d1;
            const float b0 = biasq[d0], b1 = biasq[d1];
            p0[r] = e0 >= 0 ? p0[r] + b0 : NEG; p1[r] = e1 >= 0 ? p1[r] + b1 : NEG;
        }
    }
}
__device__ __forceinline__ void partialSM(f32x16& p0, f32x16& p1, float& m_reg, float& mn, float& alpha) {
    float pmax = p0[0]; for (int r = 1; r < 16; ++r) pmax = fmaxf(pmax, p0[r]); for (int r = 0; r < 16; ++r) pmax = fmaxf(pmax, p1[r]);
    { auto rr = __builtin_amdgcn_permlane32_swap(__float_as_uint(pmax), __float_as_uint(pmax), false, false);
      pmax = fmaxf(__uint_as_float(rr[0]), __uint_as_float(rr[1])); }
    constexpr float C2 = 1.4426950408889634f * SCALE;
    if (__builtin_expect(__all((pmax - m_reg) * SCALE <= THR), 1)) { mn = m_reg; alpha = 1.f; }
    else { mn = fmaxf(m_reg, pmax); alpha = __builtin_amdgcn_exp2f((m_reg - mn) * C2); m_reg = mn; }
    const float mnL = -mn * C2;
    for (int r = 0; r < 16; ++r) p0[r] = fmaf(p0[r], C2, mnL); for (int r = 0; r < 16; ++r) p1[r] = fmaf(p1[r], C2, mnL);
    for (int r = 0; r < 16; ++r) p0[r] = __builtin_amdgcn_exp2f(p0[r]);
}
__device__ __forceinline__ void finishSM(f32x16& p0, f32x16& p1, float alpha, float& l_reg, bf16x8& pa0, bf16x8& pa1, bf16x8& pa2, bf16x8& pa3) {
    for (int r = 0; r < 16; ++r) p1[r] = __builtin_amdgcn_exp2f(p1[r]);
    float ps = 0; for (int r = 0; r < 16; ++r) ps += p0[r]; for (int r = 0; r < 16; ++r) ps += p1[r];
    { auto rr = __builtin_amdgcn_permlane32_swap(__float_as_uint(ps), __float_as_uint(ps), false, false);
      ps = __uint_as_float(rr[0]) + __uint_as_float(rr[1]); }
    l_reg = l_reg * alpha + ps;
#define PK4(P, B_, OUT) do { unsigned a0 = cvtpk(P[B_+0], P[B_+1]), a1 = cvtpk(P[B_+2], P[B_+3]);                          \
        unsigned b0 = cvtpk(P[B_+4], P[B_+5]), b1 = cvtpk(P[B_+6], P[B_+7]);                                             \
        auto r0 = __builtin_amdgcn_permlane32_swap(a0, b0, false, false); auto r1 = __builtin_amdgcn_permlane32_swap(a1, b1, false, false); \
        u32x4 w = {r0[0], r1[0], r0[1], r1[1]}; OUT = *reinterpret_cast<bf16x8*>(&w); } while (0)
    PK4(p0, 0, pa0); PK4(p0, 8, pa1); PK4(p1, 0, pa2); PK4(p1, 8, pa3);
#undef PK4
}
template <int KB>
__device__ __forceinline__ void qkt(f32x16& p0, f32x16& p1, const char* K_lds, int r32, int hi, const char* qf) {
    p0 = f32x16{}; p1 = f32x16{};
    const char* kb[4];
#pragma unroll
    for (int dd = 0; dd < 4; ++dd) kb[dd] = K_lds + KB * SHM_K + KSWZ(r32, (dd * 16 + hi * 8) * 2);
#pragma unroll
    for (int d0 = 0; d0 < 8; ++d0) { const char* a = kb[d0 & 3] + (d0 >> 2) * 128;
        bf16x8 b0 = *reinterpret_cast<const bf16x8*>(a);
        bf16x8 b1 = *reinterpret_cast<const bf16x8*>(a + 32 * 256);
        const bf16x8 qd = *reinterpret_cast<const bf16x8*>(qf + d0 * 1024);
        p0 = __builtin_amdgcn_mfma_f32_32x32x16_bf16(b0, qd, p0, 0, 0, 0);
        p1 = __builtin_amdgcn_mfma_f32_32x32x16_bf16(b1, qd, p1, 0, 0, 0); }
}
template <int VB>
__device__ __forceinline__ void pv_tile(f32x16* o, int vb0, bf16x8 pa0, bf16x8 pa1, bf16x8 pa2, bf16x8 pa3) {
#define TRRD(dst, off) asm volatile("ds_read_b64_tr_b16 %0, %1 offset:%2" : "=&v"(dst) : "v"(vb0), "i"(off) : "memory")
#define PV_D0(d0) do { s16x4 l0, l1, l2, l3, h0, h1, h2, h3; constexpr int b_ = VB * SHM_V + v_rd_off(d0, 0, 0); \
        TRRD(l0, b_); TRRD(h0, b_ + 2048); TRRD(l1, b_ + 4096); TRRD(h1, b_ + 6144); TRRD(l2, b_ + 8192); TRRD(h2, b_ + 10240); TRRD(l3, b_ + 12288); TRRD(h3, b_ + 14336); \
        asm volatile("s_waitcnt lgkmcnt(0)" ::: "memory"); SBAR();   \
        o[d0] = __builtin_amdgcn_mfma_f32_32x32x16_bf16(pa0, (bf16x8){l0[0], l0[1], l0[2], l0[3], h0[0], h0[1], h0[2], h0[3]}, o[d0], 0, 0, 0);   \
        o[d0] = __builtin_amdgcn_mfma_f32_32x32x16_bf16(pa1, (bf16x8){l1[0], l1[1], l1[2], l1[3], h1[0], h1[1], h1[2], h1[3]}, o[d0], 0, 0, 0);   \
        o[d0] = __builtin_amdgcn_mfma_f32_32x32x16_bf16(pa2, (bf16x8){l2[0], l2[1], l2[2], l2[3], h2[0], h2[1], h2[2], h2[3]}, o[d0], 0, 0, 0);   \
        o[d0] = __builtin_amdgcn_mfma_f32_32x32x16_bf16(pa3, (bf16x8){l3[0], l3[1], l3[2], l3[3], h3[0], h3[1], h3[2], h3[3]}, o[d0], 0, 0, 0); } while (0)
    PV_D0(0); PV_D0(1); PV_D0(2); PV_D0(3);
#undef PV_D0
#undef TRRD
}

struct BlockRef { const bf16* Q; const bf16* K; const bf16* V; unsigned char* O;     const float* kmean; const float* relh; int P0; };
struct Seam { bf16x8 qr[8]; bf16x8 st_v0, st_v1, st_k0, st_k1; };
#define VMW() asm volatile("s_waitcnt vmcnt(0)" ::: "memory")
#define VMWN(n) asm volatile("s_waitcnt vmcnt(%0)" :: "i"(n) : "memory")
#define SLOAD_H(Kp, Vp, k0) do { const bf16* kt_ = (Kp) + (size_t)(k0) * PITCH; const bf16* vt_ = (Vp) + (size_t)(k0) * PITCH;                    \
                         S.st_v0 = load8(vt_ + ko0); S.st_v1 = load8(vt_ + ko1); S.st_k0 = load8(kt_ + ko0); S.st_k1 = load8(kt_ + ko1); } while (0)
#define SWRITE_HK(bf) do { *(bf16x8*)(K_lds + (bf) * SHM_K + kws) = S.st_k0; *(bf16x8*)(K_lds + (bf) * SHM_K + kws + 32 * 256) = S.st_k1; } while (0)
#define SWRITE_HV(bf) do { *(bf16x8*)(V_lds + (bf) * SHM_V + vst0) = S.st_v0; *(bf16x8*)(V_lds + (bf) * SHM_V + vst1) = S.st_v1; } while (0)
#define SWRITE_H(bf) do { SWRITE_HV(bf); SWRITE_HK(bf); } while (0)
__device__ __forceinline__ void moba_prime(const BlockRef& cur, char* lds, Seam& S) {
    const int tid = threadIdx.x, wid = __builtin_amdgcn_readfirstlane(tid >> 6), lane = tid & 63, r32 = lane & 31, hi = lane >> 5;
    const int sr = tid >> 4, sc = (tid & 15) * 8, kws = KSWZ(sr, sc * 2); char* K_lds = lds + 2 * SHM_V;
    const unsigned ko0 = (unsigned)(sr * PITCH + sc), ko1 = ko0 + 32u * PITCH, qo = (unsigned)((wid * QBLK + r32) * PITCH + hi * 8);
    for (int d0 = 0; d0 < 8; ++d0) S.qr[d0] = load8(cur.Q + qo + d0 * 16);
    SLOAD_H(cur.K, cur.V, 0); VMW(); SWRITE_HK(0);
    __syncthreads();
}
__device__ __forceinline__ void moba_block(const BlockRef& cur, const BlockRef& nxt, char* lds, Seam& S) {
    const int tid = threadIdx.x, wid = __builtin_amdgcn_readfirstlane(tid >> 6), lane = tid & 63, r32 = lane & 31, hi = lane >> 5;
    const int NT = (cur.P0 + QB) / KVBLK;
    const int qlo = cur.P0 + wid * QBLK, qpos = qlo + r32;
    char* V_lds = lds; char* K_lds = lds + 2 * SHM_V;
    float* ws = (float*)(lds + LDS_WS) + wid * 64; float* li_l = ws, * al_l = ws + 32;
    float* km_l = (float*)(lds + LDS_KM); float* bq_l = (float*)(lds + LDS_BQ);
    float m_reg = -1e30f, l_reg = 0; f32x16 o[4] = {};
    const int sr = tid >> 4, sc = (tid & 15) * 8, vst0 = v_st(sr, sc), vst1 = v_st(32 + sr, sc), kws = KSWZ(sr, sc * 2);
    const unsigned ko0 = (unsigned)(sr * PITCH + sc), ko1 = ko0 + 32u * PITCH, qo = (unsigned)((wid * QBLK + r32) * PITCH + hi * 8);
    const int vb0 = (int)(uintptr_t)V_lds + v_rd_base(lane);
    const bf16* Kh = cur.K; const bf16* Vh = cur.V;
    char* qf = lds + LDS_Q + wid * 8192 + lane * 16;
#pragma unroll
    for (int d0 = 0; d0 < 8; ++d0) *reinterpret_cast<bf16x8*>(qf + d0 * 1024) = S.qr[d0];
    { const float2 km = *(const float2*)(cur.kmean + tid * 2); *(float2*)(km_l + tid * 2) = km;
      if (tid < 144) { float bv = 0.f;
          if (tid < 128) { int bk = tid; if (tid >= 16) { bk = 16 + (int)(__log2f((float)tid * 0.0625f) * (16.0f / 3.0f)); bk = bk > 31 ? 31 : bk; }
              bv = (cur.relh[bk * NHEAD] - cur.relh[31 * NHEAD]) * (1.0f / SCALE); }
          bq_l[tid] = bv; } }
    __syncthreads();
    unsigned selbits = 0u;
    { const int qb = cur.P0 >> 8;
      float g[7];
#pragma unroll
      for (int n = 0; n < 7; ++n) { g[n] = 0.f;
          if (n < qb) { float s = 0.f;
#pragma unroll
              for (int d0 = 0; d0 < 8; ++d0) { const f32x4 k0 = *(const f32x4*)(km_l + n * 128 + d0 * 16 + hi * 8), k1 = *(const f32x4*)(km_l + n * 128 + d0 * 16 + hi * 8 + 4);
                  const bf16x8 q = S.qr[d0];
                  s = fmaf(__uint_as_float((unsigned)(unsigned short)q[0] << 16), k0[0], s); s = fmaf(__uint_as_float((unsigned)(unsigned short)q[1] << 16), k0[1], s);
                  s = fmaf(__uint_as_float((unsigned)(unsigned short)q[2] << 16), k0[2], s); s = fmaf(__uint_as_float((unsigned)(unsigned short)q[3] << 16), k0[3], s);
                  s = fmaf(__uint_as_float((unsigned)(unsigned short)q[4] << 16), k1[0], s); s = fmaf(__uint_as_float((unsigned)(unsigned short)q[5] << 16), k1[1], s);
                  s = fmaf(__uint_as_float((unsigned)(unsigned short)q[6] << 16), k1[2], s); s = fmaf(__uint_as_float((unsigned)(unsigned short)q[7] << 16), k1[3], s); }
              auto rr = __builtin_amdgcn_permlane32_swap(__float_as_uint(s), __float_as_uint(s), false, false);
              g[n] = __uint_as_float(rr[0]) + __uint_as_float(rr[1]); } }
#pragma unroll
      for (int n = 0; n < 7; ++n) { if (n < qb) { int rank = 0;
#pragma unroll
              for (int m2 = 0; m2 < 7; ++m2) { if (m2 != n && m2 < qb) rank += (g[m2] > g[n] || (g[m2] == g[n] && m2 < n)) ? 1 : 0; }
              if (rank < 3) selbits |= 1u << n; } } }
#define RESC(a) do { if (__any((a) < 1.f)) { if (hi == 0) al_l[r32] = (a); asm volatile("s_waitcnt lgkmcnt(0)" ::: "memory");              \
                     for (int d_ = 0; d_ < 4; ++d_) for (int r = 0; r < 16; ++r) o[d_][r] *= al_l[crow(r, hi)]; } } while (0)
#define KBASE(t) ((t) * KVBLK)
#ifdef NOMASK
#define MASKT(P0_, P1_, t) do {} while (0)
#else
#define MASKT(P0_, P1_, t) moba_mask(P0_, P1_, KBASE(t), qpos, qlo, hi, cur.P0, selbits, bq_l)
#endif
    constexpr int NQL = 8;
#define SEAM_K0() do { VMWN(NQL); SWRITE_HK(0); SBAR(); } while (0)
    f32x16 pA0, pA1, pB0, pB1; float mnA, mnB, alA, alB; bf16x8 pa0, pa1, pa2, pa3;
    SWRITE_HV(0); SBAR();
    if (NT > 1) SLOAD_H(Kh, Vh, KBASE(1));
    SBAR(); qkt<0>(pA0, pA1, K_lds, r32, hi, qf);
    MASKT(pA0, pA1, 0); partialSM(pA0, pA1, m_reg, mnA, alA);
    if (NT > 1) { VMW(); SWRITE_H(1); }
    __syncthreads();
#define HALF_STEP(PX0, PX1, mnX, alX, PY0, PY1, alY, t, KB, VB, SB) do {                                                      \
        SBAR(); qkt<KB>(PX0, PX1, K_lds, r32, hi, qf);                                                                      \
        finishSM(PY0, PY1, alY, l_reg, pa0, pa1, pa2, pa3); SBAR();                                                           \
        if ((t) + 1 < NT) { SLOAD_H(Kh, Vh, KBASE((t) + 1)); SBAR(); }                                                        \
        pv_tile<VB>(o, vb0, pa0, pa1, pa2, pa3); MASKT(PX0, PX1, (t)); partialSM(PX0, PX1, m_reg, mnX, alX);                  \
        __syncthreads();                                                                                                      \
        if ((t) + 1 < NT) { VMW(); SWRITE_H(SB); }                                                                            \
        RESC(alX); __syncthreads(); } while (0)
    for (int t = 1; t + 1 < NT; t += 2) {
        HALF_STEP(pB0, pB1, mnB, alB, pA0, pA1, alA, t, 1, 0, 0);
        HALF_STEP(pA0, pA1, mnA, alA, pB0, pB1, alB, t + 1, 0, 1, 1);
    }
    const bool even = (NT & 1) == 0;
    if (even) { SBAR(); qkt<1>(pB0, pB1, K_lds, r32, hi, qf); SBAR(); }
    SLOAD_H(nxt.K, nxt.V, 0); SBAR();
#pragma unroll
    for (int d0 = 0; d0 < 8; ++d0) S.qr[d0] = load8(nxt.Q + qo + d0 * 16);
    SBAR();
    finishSM(pA0, pA1, alA, l_reg, pa0, pa1, pa2, pa3); SBAR();
    pv_tile<0>(o, vb0, pa0, pa1, pa2, pa3);
    if (even) { MASKT(pB0, pB1, NT - 1); partialSM(pB0, pB1, m_reg, mnB, alB); __syncthreads(); RESC(alB);
        finishSM(pB0, pB1, alB, l_reg, pa0, pa1, pa2, pa3); SBAR(); pv_tile<1>(o, vb0, pa0, pa1, pa2, pa3); }
    SBAR(); SEAM_K0();
    if (hi == 0) li_l[r32] = l_reg; asm volatile("s_waitcnt lgkmcnt(0)" ::: "memory");
    float rli[16];
#pragma unroll
    for (int r = 0; r < 16; ++r) rli[r] = __builtin_amdgcn_rcpf(li_l[crow(r, hi)]) * ATT_SCALE;
    unsigned char* Ow = cur.O + (size_t)(wid * QBLK) * PITCH;
#pragma unroll
    for (int r = 0; r < 16; ++r) { const int orow = crow(r, hi);
#pragma unroll
        for (int d0 = 0; d0 < 4; ++d0) {
            const unsigned b = (unsigned)(int)rintf(fminf(fmaxf(o[d0][r] * rli[r], -127.f), 127.f)) & 255u;
            const unsigned w = b | ((unsigned)__builtin_amdgcn_update_dpp(0, (int)b, 0xB1, 0xF, 0xF, false) << 8);
            const unsigned w2 = w | ((unsigned)__builtin_amdgcn_update_dpp(0, (int)w, 0x4E, 0xF, 0xF, false) << 16);
            if ((r32 & 3) == 0) *(unsigned*)(Ow + (size_t)orow * PITCH + d0 * 32 + r32) = w2; } }
    __syncthreads();
#undef RESC
#undef KBASE
#undef MASKT
#undef SEAM_K0
#undef HALF_STEP
}
#undef VMW
#undef VMWN
#undef SLOAD_H
#undef SWRITE_HK
#undef SWRITE_HV
#undef SWRITE_H
#undef KSWZ
#undef SBAR
}
#define XB_TMO      128
#define XB_XCNT(j)  (256  + 64 * (j))
#define XB_XSUB(j)  (1280 + 64 * (j))
#define XB_XGEN(j)  (2304 + 64 * (j))
#define XB_TOP      3328
#define XB_TOPGEN   3392
#define XCD_BAR_WORDS 3456
#define XB_SPIN_CAP (1u << 18)
#define LAS __attribute__((address_space(3)))

__device__ __forceinline__ unsigned xb_ld(unsigned* p)              { return __hip_atomic_load(p, __ATOMIC_RELAXED, __HIP_MEMORY_SCOPE_AGENT); }
__device__ __forceinline__ unsigned xb_add(unsigned* p, unsigned v) { return __hip_atomic_fetch_add(p, v, __ATOMIC_RELAXED, __HIP_MEMORY_SCOPE_AGENT); }
__device__ __forceinline__ unsigned xb_xcc_id() { return (unsigned)__builtin_amdgcn_s_getreg((3 << 11) | 20) & 0xFu; }
#define XB_SPIN(cond, bar) do { unsigned _sp = 0; while (cond) { __builtin_amdgcn_s_sleep(1); \
    if ((++_sp & 255u) == 0u) { if (xb_ld(&(bar)[XB_TMO])) break; if (_sp > XB_SPIN_CAP) { atomicAdd(&(bar)[XB_TMO], 1u); break; } } } } while (0)

struct XcdBarrier {
    unsigned* bar; unsigned x;
    volatile LAS unsigned* st;
};

__device__ __forceinline__ XcdBarrier xcd_barrier_post(unsigned* bar, volatile LAS unsigned* st) {
    XcdBarrier b; b.bar = bar; b.x = xb_xcc_id(); b.st = st;
    if (threadIdx.x == 0) (void)xb_add(&bar[XB_XCNT(b.x)], 1u);
    return b;
}
__device__ __forceinline__ void xcd_barrier_complete(unsigned* bar, unsigned x, unsigned& nloc, unsigned& nx) {
    const unsigned G = gridDim.x * gridDim.y * gridDim.z;
    unsigned sum, cnt, mine, sp = 0u;
    for (;;) {
        sum = 0u; cnt = 0u; mine = 0u;
#pragma unroll
        for (unsigned j = 0; j < 16; ++j) { const unsigned c = xb_ld(&bar[XB_XCNT(j)]); sum += c; cnt += (c > 0u) ? 1u : 0u; mine = (j == x) ? c : mine; }
        if (sum == G) break;
        __builtin_amdgcn_s_sleep(1);
        if ((++sp & 255u) == 0u) { if (xb_ld(&bar[XB_TMO])) break; if (sp > XB_SPIN_CAP) { atomicAdd(&bar[XB_TMO], 1u); break; } }
    }
    nloc = mine > 0u ? mine : 1u; nx = cnt > 0u ? cnt : 1u;
}

__device__ __forceinline__ void xcd_barrier(const XcdBarrier& b) {
    asm volatile("s_waitcnt vmcnt(0)" ::: "memory");
    __syncthreads();
    if (threadIdx.x == 0) {
        unsigned* bar = b.bar;
        __builtin_amdgcn_s_waitcnt(0);
        unsigned nloc = b.st[0], nx = b.st[1];
        if (nloc == 0u) { xcd_barrier_complete(bar, b.x, nloc, nx); b.st[0] = nloc; b.st[1] = nx; }
        const unsigned old = xb_add(&bar[XB_XSUB(b.x)], 1u);
        const unsigned gen = old / nloc;
        if (old + 1u == (gen + 1u) * nloc) {
            __builtin_amdgcn_fence(__ATOMIC_RELEASE, "agent");
            asm volatile("s_waitcnt vmcnt(0)" ::: "memory");
            const unsigned og = xb_add(&bar[XB_TOP], 1u);
            const unsigned tg = og / nx;
            if (og + 1u == (tg + 1u) * nx) xb_add(&bar[XB_TOPGEN], 1u);
            else XB_SPIN(xb_ld(&bar[XB_TOPGEN]) == tg, bar);
            __builtin_amdgcn_fence(__ATOMIC_ACQUIRE, "agent");
            xb_add(&bar[XB_XGEN(b.x)], 1u);
            asm volatile("s_waitcnt vmcnt(0)" ::: "memory");
        } else {
            XB_SPIN(xb_ld(&bar[XB_XGEN(b.x)]) == gen, bar);
            __builtin_amdgcn_fence(__ATOMIC_ACQUIRE, "agent");
            asm volatile("s_waitcnt vmcnt(0)" ::: "memory");
        }
    }
    __syncthreads();
}


constexpr int NWAVES = 8, NTHR = NWAVES * 64;
constexpr int BATCH = 4, SEQ = 2048, M = BATCH * SEQ, DM = 4096, NPROJ = 20480, AW = 2048, NH = 16, HD = 128, LBLK = 256, NBLK = 8;
constexpr int PH = 8, NKEY = 128, QD = 256, PHALF = 128, TOPK = 16, NEXP = 16384, PQW = PH * QD, NSLOT = PH * TOPK;
constexpr float NORM_EPS = 1e-6f;
constexpr int NGATE0 = 2048;
constexpr unsigned long long SLABS_BF16 = 0x5ull, SLABS_I8 = 0x987643210ull;
__host__ __device__ constexpr int slab_is_i8(int s) { return s != 5; }
__host__ __device__ constexpr int slab_pos(int s) { return s < 5 ? s : (s == 5 ? 0 : s - 1); }
constexpr float HQ_SCALE = 127.0f / 5.5f;
constexpr float WB8_SCALE = 127.0f * 45.254834f / 4.0f;
constexpr float W8_SCALE = 127.0f * 64.0f / 4.0f;
constexpr float U_STEP = 0.3352f / 64.0f;
constexpr float V_SCALE = 22.627417f;
typedef float f32x2v __attribute__((ext_vector_type(2)));
#ifndef MK_N_LAUNCHES
#define MK_N_LAUNCHES 1
#endif
constexpr int N_PHASES = 12;
#ifndef DUP_PHASE
#define DUP_PHASE (-1)
#endif
#ifndef P9_DUP_PART
#define P9_DUP_PART 0
#endif
#ifndef P9_VALU_REPS
#define P9_VALU_REPS 1
#endif
#ifndef GEMM_DUP
#define GEMM_DUP 0
#endif
#define GDUP(b) (((GEMM_DUP >> (b)) & 1) ? 2 : 1)
#ifndef PEER_SLICED
#define PEER_SLICED 1
#endif
#ifndef PHASE_MASK
#define PHASE_MASK 0xfff
#endif
constexpr int N_LAUNCHES = MK_N_LAUNCHES;

constexpr size_t MiB = 1u << 20;
constexpr size_t WS_CTL = 0, CTL_ZERO_BYTES = 1 * MiB;
constexpr size_t WS_WT_IN = 2 * MiB;
constexpr size_t WS_WT_BRA = WS_WT_IN + 160 * MiB;
constexpr size_t WS_WT_BRC = WS_WT_BRA + 16 * MiB;
constexpr size_t WS_WT_OUT = WS_WT_BRC + 16 * MiB;
constexpr size_t WS_WT_PQ = WS_WT_OUT + 32 * MiB;
constexpr size_t WS_UB = WS_WT_PQ + 16 * MiB;
constexpr size_t WS_VB = WS_UB + 128 * MiB;
constexpr size_t WS_HN = WS_VB + 128 * MiB;
constexpr size_t WS_PROJ = WS_HN + 64 * MiB;
constexpr size_t WS_ATT = WS_PROJ + 320 * MiB;
constexpr size_t WS_CONV = WS_ATT + 32 * MiB;
constexpr size_t WS_MRG = WS_CONV + 32 * MiB;
constexpr size_t WS_KMEAN = WS_MRG + 64 * MiB;
constexpr size_t WS_EIDX = WS_KMEAN + 1 * MiB;
constexpr size_t WS_EG = WS_EIDX + 4 * MiB;
constexpr size_t WS_KHI = WS_EG + 4 * MiB;
constexpr size_t WS_KLO = WS_KHI + 512 * 1024;
constexpr size_t WS_HN8 = WS_KLO + 512 * 1024;
constexpr size_t WS_SX = WS_HN8 + 32 * MiB;
constexpr size_t WS_END = WS_SX + 64 * 1024;
constexpr size_t WS_H1 = WS_PROJ;
constexpr size_t WS_QP = WS_PROJ + 128 * MiB;
constexpr size_t PROJ_TS = (size_t)M * AW;
static_assert(WS_QP + (size_t)M * PQW * 4 <= WS_ATT, "overlay fits");
constexpr int CW_BAR = 4096;
constexpr size_t WS_ROWCS = WS_CTL + 320 * 1024;
constexpr size_t WS_ROWSS = WS_CTL + 256 * 1024;

constexpr int RING_BYTES = 131072;
constexpr int LDSCTL_OFF = 155648, LDS_BYTES = LDSCTL_OFF + 1024;
static_assert(moba::LDS_BYTES <= LDSCTL_OFF, "LDS map");

#define GAS __attribute__((address_space(1)))
typedef unsigned short bf16;
typedef unsigned v4u __attribute__((ext_vector_type(4)));
typedef unsigned v2u __attribute__((ext_vector_type(2)));
typedef float f32x4 __attribute__((ext_vector_type(4)));
typedef __bf16 bf2_t __attribute__((ext_vector_type(2)));
#define LDS_WAIT() asm volatile("s_waitcnt lgkmcnt(0)" ::: "memory")
#define VM_WAIT() asm volatile("s_waitcnt vmcnt(0)" ::: "memory")
__device__ __forceinline__ unsigned f2bf(float f) { unsigned u = __builtin_bit_cast(unsigned, f); return (u + 0x7fffu + ((u >> 16) & 1u)) >> 16; }
__device__ __forceinline__ unsigned pk2(float lo, float hi) { return f2bf(lo) | (f2bf(hi) << 16); }
__device__ __forceinline__ float bflo(unsigned w) { return __uint_as_float(w << 16); }
__device__ __forceinline__ float bfhi(unsigned w) { return __uint_as_float(w & 0xffff0000u); }

struct Frame {
    LAS unsigned char* lds;
    int tid, lane, wave, vcu, G;
    float* out; unsigned char* ws;
};
__device__ __forceinline__ const float* lds_in_ptr(const Frame& F, int i) {
    volatile LAS unsigned* p = (volatile LAS unsigned*)(F.lds + LDSCTL_OFF + 128) + 2 * i; const unsigned lo = p[0], hi = p[1];
    return (const float*)(const GAS float*)(((unsigned long long)(unsigned)__builtin_amdgcn_readfirstlane((int)hi) << 32) | (unsigned long long)(unsigned)__builtin_amdgcn_readfirstlane((int)lo));
}
#define F_IN(i) lds_in_ptr(F, i)
#define F_WT_IN ((bf16*)(F.ws + WS_WT_IN))
#define F_WT_BRA ((bf16*)(F.ws + WS_WT_BRA))
#define F_WT_BRC ((bf16*)(F.ws + WS_WT_BRC))
#define F_WT_OUT ((bf16*)(F.ws + WS_WT_OUT))
#define F_WT_PQ ((bf16*)(F.ws + WS_WT_PQ))
#define F_U4 ((unsigned char*)(F.ws + WS_UB))
#define F_V4 ((unsigned char*)(F.ws + WS_VB))
#define F_HN ((bf16*)(F.ws + WS_HN))
#define F_PROJ ((bf16*)(F.ws + WS_PROJ))
#define F_ATT ((bf16*)(F.ws + WS_ATT))
#define F_CONV ((bf16*)(F.ws + WS_CONV))
#define F_MRG ((bf16*)(F.ws + WS_MRG))
#define F_KMEAN ((float*)(F.ws + WS_KMEAN))
#define F_EIDX ((int*)(F.ws + WS_EIDX))
#define F_EG ((float*)(F.ws + WS_EG))
#define F_H1 ((float*)(F.ws + WS_H1))
#define F_QH ((bf16*)(F.ws + WS_QP))
#define F_QL ((bf16*)(F.ws + WS_QP + 32 * MiB))
#define F_ROWSS ((float*)(F.ws + WS_ROWSS))
#define F_ROWCS ((int*)(F.ws + WS_ROWCS))
#define F_HN8 ((unsigned char*)(F.ws + WS_HN8))
#define F_HQ8 ((unsigned char*)(F.ws + WS_HN))
#define F_WPQ8 ((unsigned char*)(F.ws + WS_WT_PQ))
#define F_SX ((float*)(F.ws + WS_SX))
#define F_W8T ((unsigned char*)(F.ws + WS_WT_IN + (size_t)NGATE0 * DM * 2))
#define F_KHI ((bf16*)(F.ws + WS_KHI))
#define F_KLO ((bf16*)(F.ws + WS_KLO))

__device__ __forceinline__ float wave_sum(float v) {
#pragma unroll
    for (int o = 1; o < 64; o <<= 1) v += __shfl_xor(v, o);
    return v;
}
__device__ __forceinline__ void p0_transpose_item(const float* W, int K, int N, bf16* WT, LAS float* scr, int item, int lane) {
    const int nblk = N / 32, kb = item / nblk, nb = item % nblk, k0 = 64 * kb, n0 = 32 * nb;
    { const GAS float* wb = (const GAS float*)W + (size_t)k0 * N + n0; const unsigned lo = (unsigned)((lane >> 5) * N + (lane & 31)); float wv[32];
#pragma unroll
      for (int i = 0; i < 32; ++i) { wv[i] = wb[lo]; wb += 2 * N; }
#pragma unroll
      for (int i = 0; i < 32; ++i) scr[(2 * i + (lane >> 5)) * 33 + (lane & 31)] = wv[i]; }
    LDS_WAIT(); asm volatile("" ::: "memory");
    const int c = lane & 7;
#pragma unroll
    for (int j = 0; j < 4; ++j) { const int n = (lane >> 3) + 8 * j; const LAS float* s = scr + (8 * c) * 33 + n;
        v4u o; o.x = pk2(s[0 * 33], s[1 * 33]); o.y = pk2(s[2 * 33], s[3 * 33]); o.z = pk2(s[4 * 33], s[5 * 33]); o.w = pk2(s[6 * 33], s[7 * 33]);
        *(GAS v4u*)(WT + (size_t)(n0 + n) * K + k0 + 8 * c) = o; }
    LDS_WAIT(); asm volatile("" ::: "memory");
}
__device__ __forceinline__ void rms_row_to_bf16(const float* xrow, const float* gain, bf16* orow, int lane) {
    const GAS f32x4* xr = (const GAS f32x4*)xrow + lane; const GAS f32x4* gr = (const GAS f32x4*)gain + lane;
    f32x4 v[16]; float s = 0.f;
#pragma unroll
    for (int j = 0; j < 16; ++j) { v[j] = xr[64 * j]; s += (v[j].x * v[j].x + v[j].y * v[j].y) + (v[j].z * v[j].z + v[j].w * v[j].w); }
    const float r = 1.0f / sqrtf(wave_sum(s) * (1.0f / DM) + NORM_EPS);
    GAS v2u* o8 = (GAS v2u*)orow + lane;
#pragma unroll
    for (int j = 0; j < 16; ++j) { const f32x4 g = gr[64 * j]; v2u w; w.x = pk2(v[j].x * r * g.x, v[j].y * r * g.y); w.y = pk2(v[j].z * r * g.z, v[j].w * r * g.w); o8[64 * j] = w; }
}


__device__ __forceinline__ void p0_transpose_item_i8(const float* W, int K, int N, unsigned char* WT8, int n_lo, float scale, LAS float* scr, int item, int lane) {
    const int nblk = N / 32, kb = item / nblk, nb = item % nblk, k0 = 64 * kb, n0 = 32 * nb;
    { const GAS float* wb = (const GAS float*)W + (size_t)k0 * N + n0; const unsigned lo = (unsigned)((lane >> 5) * N + (lane & 31)); float wv[32];
#pragma unroll
      for (int i = 0; i < 32; ++i) { wv[i] = wb[lo]; wb += 2 * N; }
#pragma unroll
      for (int i = 0; i < 32; ++i) scr[(2 * i + (lane >> 5)) * 33 + (lane & 31)] = wv[i]; }
    LDS_WAIT(); asm volatile("" ::: "memory");
    const int c = lane & 7;
#pragma unroll
    for (int j = 0; j < 4; ++j) { const int n = (lane >> 3) + 8 * j; const LAS float* s = scr + (8 * c) * 33 + n; unsigned q[8];
#pragma unroll
        for (int i = 0; i < 8; ++i) { int v = (int)rintf(s[i * 33] * scale); v = v < -127 ? -127 : (v > 127 ? 127 : v); q[i] = (unsigned)(v & 255); }
        v2u o; o.x = q[0] | (q[1] << 8) | (q[2] << 16) | (q[3] << 24); o.y = q[4] | (q[5] << 8) | (q[6] << 16) | (q[7] << 24);
        *(GAS v2u*)(WT8 + (size_t)(n0 - n_lo + n) * K + k0 + 8 * c) = o; }
    LDS_WAIT(); asm volatile("" ::: "memory");
}
__device__ __forceinline__ void p0_transpose_any(const float* W, int K, int N, unsigned char* dst, int drow, bool is8, float qs, LAS float* scr, int item, int lane) {
    const int nblk = N / 32, kb = item / nblk, nb = item - kb * nblk, k0 = 128 * kb, n0 = 32 * nb;
    { const GAS float* wb = (const GAS float*)W + (size_t)k0 * N + n0; const unsigned lo = (unsigned)((lane >> 5) * N + (lane & 31)); float wv[64];
#pragma unroll
      for (int i = 0; i < 64; ++i) { wv[i] = __builtin_nontemporal_load(wb + lo); wb += 2 * N; }
#pragma unroll
      for (int i = 0; i < 64; ++i) scr[(2 * i + (lane >> 5)) * 33 + (lane & 31)] = wv[i]; }
    LDS_WAIT(); asm volatile("" ::: "memory");
    const int c = lane & 7;
#pragma unroll
    for (int j = 0; j < 4; ++j) { const int n = (lane >> 3) + 8 * j; const LAS float* s = scr + (16 * c) * 33 + n; float f[16];
#pragma unroll
        for (int i = 0; i < 16; ++i) f[i] = s[i * 33];
        const size_t row = (size_t)(n0 + n + drow);
        if (is8) { unsigned q[16];
#pragma unroll
            for (int i = 0; i < 16; ++i) { int v = (int)rintf(f[i] * qs); v = v < -127 ? -127 : (v > 127 ? 127 : v); q[i] = (unsigned)(v & 255); }
            v4u o;
#pragma unroll
            for (int w = 0; w < 4; ++w) o[w] = q[4 * w] | (q[4 * w + 1] << 8) | (q[4 * w + 2] << 16) | (q[4 * w + 3] << 24);
            *(GAS v4u*)(dst + row * K + k0 + 16 * c) = o;
        } else { v4u o0, o1;
#pragma unroll
            for (int w = 0; w < 4; ++w) { o0[w] = pk2(f[2 * w], f[2 * w + 1]); o1[w] = pk2(f[8 + 2 * w], f[8 + 2 * w + 1]); }
            GAS v4u* op = (GAS v4u*)(dst + (row * K + k0 + 16 * c) * 2); op[0] = o0; op[1] = o1; } }
    LDS_WAIT(); asm volatile("" ::: "memory");
}
__device__ __forceinline__ void rms_row_to_bf16_i8(const float* xrow, const float* gain, bf16* orow, unsigned char* x8row, float* sxp, int lane) {
    const GAS f32x4* xr = (const GAS f32x4*)xrow + lane; const GAS f32x4* gr = (const GAS f32x4*)gain + lane;
    f32x4 v[16]; float s = 0.f;
#pragma unroll
    for (int j = 0; j < 16; ++j) { v[j] = __builtin_nontemporal_load(xr + 64 * j); s += (v[j].x * v[j].x + v[j].y * v[j].y) + (v[j].z * v[j].z + v[j].w * v[j].w); }
    const float r = 1.0f / sqrtf(wave_sum(s) * (1.0f / DM) + NORM_EPS);
    GAS v2u* o8 = (GAS v2u*)orow + lane; float amax = 0.f;
#pragma unroll
    for (int j = 0; j < 16; ++j) { const f32x4 g = gr[64 * j]; v[j].x = v[j].x * r * g.x; v[j].y = v[j].y * r * g.y; v[j].z = v[j].z * r * g.z; v[j].w = v[j].w * r * g.w;
        if (NGATE0 > 0) { v2u w; w.x = pk2(v[j].x, v[j].y); w.y = pk2(v[j].z, v[j].w); o8[64 * j] = w; }
        amax = fmaxf(fmaxf(amax, fmaxf(fabsf(v[j].x), fabsf(v[j].y))), fmaxf(fabsf(v[j].z), fabsf(v[j].w))); }
#pragma unroll
    for (int o = 1; o < 64; o <<= 1) amax = fmaxf(amax, __shfl_xor(amax, o));
    amax = fmaxf(amax, 1e-20f); const float isx = 127.0f / amax;
    GAS unsigned* x8 = (GAS unsigned*)x8row + lane;
#pragma unroll
    for (int j = 0; j < 16; ++j) { int q0 = (int)rintf(v[j].x * isx), q1 = (int)rintf(v[j].y * isx), q2 = (int)rintf(v[j].z * isx), q3 = (int)rintf(v[j].w * isx);
        q0 = q0 < -127 ? -127 : (q0 > 127 ? 127 : q0); q1 = q1 < -127 ? -127 : (q1 > 127 ? 127 : q1); q2 = q2 < -127 ? -127 : (q2 > 127 ? 127 : q2); q3 = q3 < -127 ? -127 : (q3 > 127 ? 127 : q3);
        x8[64 * j] = (unsigned)(q0 & 255) | ((unsigned)(q1 & 255) << 8) | ((unsigned)(q2 & 255) << 16) | ((unsigned)(q3 & 255) << 24); }
    if (lane == 0) *sxp = amax * (1.0f / 127.0f);
}

constexpr int TBL_NCH = (int)((size_t)NEXP * DM / 2048);
__device__ __forceinline__ void tbl_load(const float* pu, const float* pv, int c, int lane, f32x4 (&a)[8]) {
    const bool isu = c < TBL_NCH; const int cc = isu ? c : c - TBL_NCH;
    const GAS f32x4* src = (const GAS f32x4*)((isu ? pu : pv) + (size_t)cc * 2048) + lane;
#pragma unroll
    for (int j = 0; j < 8; ++j) a[j] = __builtin_nontemporal_load(src + j * 64);
}
__device__ __forceinline__ void tbl_store(unsigned char* u4, unsigned char* v4t, int c, int lane, const f32x4 (&a)[8]) {
    const bool isu = c < TBL_NCH; const int cc = isu ? c : c - TBL_NCH;
    GAS v4u* dst = (GAS v4u*)((isu ? u4 : v4t) + (size_t)cc * 1024) + lane;
    v4u o;
    if (isu) {
#pragma unroll
        for (int m = 0; m < 4; ++m) { unsigned w = 0u;
#pragma unroll
            for (int i = 0; i < 8; ++i) { const float v = a[2 * m + (i >> 2)][i & 3]; int n = (int)floorf(v * (1.0f / U_STEP)) + 8; n = n < 0 ? 0 : (n > 15 ? 15 : n); w |= (unsigned)n << (4 * i); }
            o[m] = w; }
    } else {
#pragma unroll
        for (int m = 0; m < 4; ++m) { unsigned w = 0u;
            w = __builtin_amdgcn_cvt_scalef32_pk_fp4_f32(w, a[2 * m].x * V_SCALE, a[2 * m].y * V_SCALE, 1.0f, 0); w = __builtin_amdgcn_cvt_scalef32_pk_fp4_f32(w, a[2 * m].z * V_SCALE, a[2 * m].w * V_SCALE, 1.0f, 1);
            w = __builtin_amdgcn_cvt_scalef32_pk_fp4_f32(w, a[2 * m + 1].x * V_SCALE, a[2 * m + 1].y * V_SCALE, 1.0f, 2); w = __builtin_amdgcn_cvt_scalef32_pk_fp4_f32(w, a[2 * m + 1].z * V_SCALE, a[2 * m + 1].w * V_SCALE, 1.0f, 3);
            o[m] = w; }
    }
    dst[0] = o;
}
constexpr int TBL_PER_CALL = 4;
__device__ __forceinline__ void tbl_rest(const float* pu, const float* pv, unsigned char* u4, unsigned char* v4t, int gw, int NGW, int lane, int done_units) {
    for (int c = done_units * NGW * TBL_PER_CALL + gw; c < 2 * TBL_NCH; c += NGW) { f32x4 a[8]; tbl_load(pu, pv, c, lane, a); tbl_store(u4, v4t, c, lane, a); }
}
#if PEER_SLICED
__device__ __forceinline__ void p0_tables(Frame& F, LAS unsigned* scr);
#endif
__device__ __forceinline__ void p0_prologue(Frame& F) {
    const int gw = F.vcu * NWAVES + F.wave, NGW = F.G * NWAVES, lane = F.lane;
#if PEER_SLICED
    p0_tables(F, (LAS unsigned*)(F.lds + F.wave * 16384));
#else
    { const float* pu = F_IN(13); const float* pv = F_IN(14); tbl_rest(pu, pv, F_U4, F_V4, gw, NGW, lane, 0); }
#endif
    LAS float* scr = (LAS float*)(F.lds + F.wave * 17408);
    constexpr int I_IN = (DM / 128) * (NPROJ / 32), I_BR = (AW / 128) * (DM / 32), I_OUT = (DM / 128) * (DM / 32), I_PQ = (DM / 128) * (PQW / 32);
    constexpr int NITEMS = I_IN + 2 * I_BR + I_OUT + I_PQ;
    for (int it = gw; it < NITEMS; it += NGW) {
        int r = it, widx, K_, N_, drow = 0; size_t doff; bool is8 = false; float qs = W8_SCALE;
        if (r < I_IN) { const int n0_ = (r % (NPROJ / 32)) * 32, sl_ = n0_ / AW; drow = (slab_pos(sl_) - sl_) * AW;
            widx = 2; K_ = DM; N_ = NPROJ; is8 = slab_is_i8(sl_) != 0; doff = is8 ? WS_WT_IN + (size_t)NGATE0 * DM * 2 : WS_WT_IN; }
        else if ((r -= I_IN) < I_BR) { widx = 5; K_ = AW; N_ = DM; doff = WS_WT_BRA; is8 = true; qs = WB8_SCALE; }
        else if ((r -= I_BR) < I_BR) { widx = 6; K_ = AW; N_ = DM; doff = WS_WT_BRC; }
        else if ((r -= I_BR) < I_OUT) { widx = 9; K_ = DM; N_ = DM; doff = WS_WT_OUT; }
        else { r -= I_OUT; widx = 11; K_ = DM; N_ = PQW; doff = WS_WT_PQ; is8 = true; }
        p0_transpose_any(F_IN(widx), K_, N_, F.ws + doff, drow, is8, qs, scr, r, lane);
    }
    { const int gt = F.vcu * NTHR + F.tid, NGT = F.G * NTHR;
      for (int i = gt; i < PH * 2 * NKEY * PHALF / 2; i += NGT) { const float2 kv = *(const float2*)(F_IN(12) + 2 * (size_t)i);
          const unsigned h = pk2(kv.x, kv.y); const unsigned l = pk2(kv.x - bflo(h), kv.y - bfhi(h));
          ((unsigned*)F_KHI)[i] = h; ((unsigned*)F_KLO)[i] = l; } }
    for (int m = gw; m < M; m += NGW) rms_row_to_bf16_i8(F_IN(0) + (size_t)m * DM, F_IN(1), F_HN + (size_t)m * DM, F_HN8 + (size_t)m * DM, F_SX + m, lane);
}

__device__ __forceinline__ void p2_kmean_conv(Frame& F) {
    const int gw = F.vcu * NWAVES + F.wave, NGW = F.G * NWAVES, lane = F.lane;
    const bf16* PK = F_PROJ + 1 * PROJ_TS;
    for (int pr = F.vcu; pr < BATCH * NBLK * NH / 2; pr += F.G) {
        const int it = 2 * pr + (F.wave >> 2), q = F.wave & 3, h = it % NH, n = (it / NH) % NBLK, b = it / (NH * NBLK), c = lane & 15, rg = lane >> 4;
        const bf16* kp = PK + (size_t)(b * SEQ + n * LBLK + q * 64 + rg) * AW + h * HD + 8 * c;
        float s[8];
#pragma unroll
        for (int e = 0; e < 8; ++e) s[e] = 0.f;
#pragma unroll
        for (int i = 0; i < 16; ++i) { const v4u w = *(const GAS v4u*)(kp + (size_t)(4 * i) * AW);
            s[0] += bflo(w.x); s[1] += bfhi(w.x); s[2] += bflo(w.y); s[3] += bfhi(w.y); s[4] += bflo(w.z); s[5] += bfhi(w.z); s[6] += bflo(w.w); s[7] += bfhi(w.w); }
#pragma unroll
        for (int e = 0; e < 8; ++e) { s[e] += __shfl_xor(s[e], 16); s[e] += __shfl_xor(s[e], 32); }
        LAS float* kq = (LAS float*)F.lds;
        __syncthreads();
        if (rg == 0) { *(LAS f32x4*)(kq + F.wave * 128 + 8 * c) = (f32x4){s[0], s[1], s[2], s[3]}; *(LAS f32x4*)(kq + F.wave * 128 + 8 * c + 4) = (f32x4){s[4], s[5], s[6], s[7]}; }
        __syncthreads();
        if (F.tid < 256) { const int ii = F.tid >> 7, d = F.tid & 127, it2 = 2 * pr + ii, h2 = it2 % NH, n2 = (it2 / NH) % NBLK, b2 = it2 / (NH * NBLK);
            const float tot = ((kq[(4 * ii) * 128 + d] + kq[(4 * ii + 1) * 128 + d]) + kq[(4 * ii + 2) * 128 + d]) + kq[(4 * ii + 3) * 128 + d];
            F_KMEAN[((size_t)(b2 * NH + h2) * NBLK + n2) * HD + d] = tot * (1.0f / LBLK); }
    }
    const bf16* PCB = F_PROJ + 3 * PROJ_TS; const bf16* PCC = F_PROJ + 4 * PROJ_TS; const bf16* PCU = F_PROJ + 5 * PROJ_TS;
    constexpr int CHUNK = 16, NCG = AW / 8, NITEM = (M / CHUNK) * NCG;
    const int gt = F.vcu * NTHR + F.tid, NGT = F.G * NTHR;
    for (int it = gt; it < NITEM; it += NGT) {
        const int cg = it % NCG, ch = it / NCG, t0 = ch * CHUNK, c0 = cg * 8;
        float w0[8], w1[8], w2[8], bb[8], g1[8], g2[8];
#pragma unroll
        for (int e = 0; e < 8; ++e) { w0[e] = F_IN(3)[c0 + e]; w1[e] = F_IN(3)[AW + c0 + e]; w2[e] = F_IN(3)[2 * AW + c0 + e]; bb[e] = F_IN(4)[c0 + e]; g1[e] = 0.f; g2[e] = 0.f; }
        if ((t0 % SEQ) != 0) {
            const v4u a1 = *(const GAS v4u*)(PCC + (size_t)(t0 - 1) * AW + c0), u1 = *(const GAS v4u*)(PCU + (size_t)(t0 - 1) * AW + c0);
            const v4u a2 = *(const GAS v4u*)(PCC + (size_t)(t0 - 2) * AW + c0), u2 = *(const GAS v4u*)(PCU + (size_t)(t0 - 2) * AW + c0);
#pragma unroll
            for (int q = 0; q < 4; ++q) { g1[2 * q] = bflo(a1[q]) * bflo(u1[q]); g1[2 * q + 1] = bfhi(a1[q]) * bfhi(u1[q]); g2[2 * q] = bflo(a2[q]) * bflo(u2[q]); g2[2 * q + 1] = bfhi(a2[q]) * bfhi(u2[q]); }
        }
#pragma unroll 4
        for (int t = t0; t < t0 + CHUNK; ++t) {
            const v4u cb = *(const GAS v4u*)(PCB + (size_t)t * AW + c0), a0 = *(const GAS v4u*)(PCC + (size_t)t * AW + c0), u0 = *(const GAS v4u*)(PCU + (size_t)t * AW + c0);
            float g0[8], z[8];
#pragma unroll
            for (int q = 0; q < 4; ++q) { g0[2 * q] = bflo(a0[q]) * bflo(u0[q]); g0[2 * q + 1] = bfhi(a0[q]) * bfhi(u0[q]); }
#pragma unroll
            for (int e = 0; e < 8; ++e) { const float y = w0[e] * g2[e] + w1[e] * g1[e] + w2[e] * g0[e] + bb[e]; const float cbv = (e & 1) ? bfhi(cb[e >> 1]) : bflo(cb[e >> 1]); z[e] = cbv * y; g2[e] = g1[e]; g1[e] = g0[e]; }
            v4u o; o.x = pk2(z[0], z[1]); o.y = pk2(z[2], z[3]); o.z = pk2(z[4], z[5]); o.w = pk2(z[6], z[7]);
            *(GAS v4u*)(F_CONV + (size_t)t * AW + c0) = o;
        }
    }
}

__device__ __forceinline__ moba::BlockRef attn_ref(const Frame& F, int b, int h, int qb) {
    moba::BlockRef r;
    const size_t qoff = (size_t)(b * SEQ + qb * LBLK) * AW + h * HD, koff = (size_t)(b * SEQ) * AW + h * HD;
    r.Q = F_PROJ + qoff; r.K = F_PROJ + PROJ_TS + koff; r.V = F_PROJ + 2 * PROJ_TS + koff; r.O = (unsigned char*)F_ATT + qoff;
    r.kmean = F_KMEAN + (size_t)(b * NH + h) * NBLK * HD; r.relh = F_IN(8) + h; r.P0 = qb * LBLK;
    return r;
}
__device__ __forceinline__ void p3_attention(Frame& F, char* lds) {
    for (int L = F.vcu; L < BATCH * NH * 4; L += F.G) {
        const int bh = L >> 2, y = L & 3, b = bh / NH, h = bh % NH;
        moba::Seam S;
        moba::BlockRef cur = attn_ref(F, b, h, y);
        const moba::BlockRef heavy = attn_ref(F, b, h, NBLK - 1 - y);
        moba::moba_prime(cur, lds, S);
#pragma unroll 1
        for (int pass = 0; pass < 2; ++pass) {
            moba::moba_block(cur, heavy, lds, S);
            cur = heavy;
        }
    }
}

typedef float f32x16 __attribute__((ext_vector_type(16)));
typedef short bf16x8v __attribute__((ext_vector_type(8)));
__device__ __forceinline__ unsigned f2key(float f) { const unsigned u = __float_as_uint(f); return u ^ ((unsigned)((int)u >> 31) | 0x80000000u); }
__device__ __forceinline__ float key2f(unsigned k) { return __uint_as_float((k & 0x80000000u) ? (k ^ 0x80000000u) : ~k); }
__device__ __forceinline__ unsigned umed3(unsigned a, unsigned b, unsigned c) { unsigned d; asm("v_med3_u32 %0, %1, %2, %3" : "=v"(d) : "v"(a), "v"(b), "v"(c)); return d; }
__device__ __forceinline__ void key_insert(unsigned (&tk)[16], unsigned x) {
#pragma unroll
    for (int s = 15; s >= 1; --s) tk[s] = umed3(tk[s - 1], tk[s], x);
    tk[0] = tk[0] > x ? tk[0] : x;
}
constexpr int P8_KEYS = 32768, P8_KPITCH = 272;
constexpr int PK_LIST = 0;
__device__ __forceinline__ void p8_peer_topk(Frame& F) {
    const int gw = F.vcu * NWAVES + F.wave, NGW = F.G * NWAVES, lane = F.lane, r32 = lane & 31, hi = lane >> 5;
    LAS int* LST = (LAS int*)(F.lds + PK_LIST) + F.wave * 1024;
    for (int task = gw; task < (M / 32) * PH; task += NGW) {
        const int h = (task >> 3) % PH, t0 = ((task >> 6) * 8 + (task & 7)) * 32;
        unsigned kl[2][16];
#pragma unroll
        for (int j = 0; j < 2; ++j) {
            bf16x8v qh[8];
            const size_t qoff = (size_t)(t0 + r32) * PQW + h * QD + j * PHALF + hi * 8;
#pragma unroll
            for (int d0 = 0; d0 < 8; ++d0) { qh[d0] = *(const GAS bf16x8v*)(F_QH + qoff + d0 * 16); }
            __syncthreads();
            { const GAS v4u* sh = (const GAS v4u*)(F_KHI + (size_t)(h * 2 + j) * NKEY * PHALF); const GAS v4u* sl = (const GAS v4u*)(F_KLO + (size_t)(h * 2 + j) * NKEY * PHALF);
              v4u th[4], tl[4];
#pragma unroll
              for (int i = 0; i < 4; ++i) { th[i] = sh[F.tid + 512 * i]; tl[i] = sl[F.tid + 512 * i]; }
#pragma unroll
              for (int i = 0; i < 4; ++i) { const int c = F.tid + 512 * i, off = (c >> 4) * P8_KPITCH + (c & 15) * 16; *(LAS v4u*)(F.lds + P8_KEYS + off) = th[i]; *(LAS v4u*)(F.lds + P8_KEYS + NKEY * P8_KPITCH + off) = tl[i]; } }
            __syncthreads();
            f32x16 p[4];
#pragma unroll
            for (int blk = 0; blk < 4; ++blk) { p[blk] = f32x16{};
                const int koff = (blk * 32 + r32) * P8_KPITCH + hi * 16;
#pragma unroll
                for (int d0 = 0; d0 < 8; ++d0) { const bf16x8v kh = *(const LAS bf16x8v*)(F.lds + P8_KEYS + koff + d0 * 32), kl_ = *(const LAS bf16x8v*)(F.lds + P8_KEYS + NKEY * P8_KPITCH + koff + d0 * 32);
                    p[blk] = __builtin_amdgcn_mfma_f32_32x32x16_bf16(kl_, qh[d0], p[blk], 0, 0, 0);
                    p[blk] = __builtin_amdgcn_mfma_f32_32x32x16_bf16(kh, qh[d0], p[blk], 0, 0, 0); } }
            unsigned tk[16];
#pragma unroll
            for (int s = 0; s < 16; ++s) tk[s] = 0u;
#pragma unroll
            for (int blk = 0; blk < 4; ++blk)
#pragma unroll
                for (int r = 0; r < 16; ++r) { const int kidx = blk * 32 + (r & 3) + 8 * (r >> 2) + 4 * hi; key_insert(tk, (f2key(p[blk][r]) & ~127u) | (unsigned)(127 - kidx)); }
            unsigned pk[16];
#pragma unroll
            for (int s = 0; s < 16; ++s) pk[s] = (unsigned)__shfl_xor((int)tk[s], 32);
#pragma unroll
            for (int s = 0; s < 16; ++s) key_insert(tk, pk[s]);
#pragma unroll
            for (int s = 0; s < 16; ++s) kl[j][s] = tk[s];
        }
        if (hi == 0) {
#pragma unroll
            for (int s = 0; s < 16; ++s) { LST[r32 * 32 + s] = 127 - (int)(kl[0][s] & 127u); LST[r32 * 32 + 16 + s] = 127 - (int)(kl[1][s] & 127u); } }
        float v1[16], v2[16];
#pragma unroll
        for (int s = 0; s < 16; ++s) { v1[s] = key2f(kl[0][s] & ~127u); v2[s] = key2f(kl[1][s] & ~127u); }
        unsigned tk[16];
#pragma unroll
        for (int s = 0; s < 16; ++s) tk[s] = 0u;
#pragma unroll
        for (int a = 0; a < 16; ++a)
#pragma unroll
            for (int b = 0; b < 16; ++b) if ((a + 1) * (b + 1) <= 16) key_insert(tk, (f2key(v1[a] + v2[b]) & ~255u) | (unsigned)(255 - (a * 16 + b)));
        float ex[16], den = 0.f; const float mx = key2f(tk[0] & ~255u);
#pragma unroll
        for (int s = 0; s < 16; ++s) { ex[s] = __expf(key2f(tk[s] & ~255u) - mx); den += ex[s]; }
        const float inv = 1.0f / den;
        asm volatile("s_waitcnt lgkmcnt(0)" ::: "memory");
        int* eo = F_EIDX + (size_t)(t0 + r32) * NSLOT + h * TOPK + hi * 8; float* go = F_EG + (size_t)(t0 + r32) * NSLOT + h * TOPK + hi * 8;
        int ev[8]; float gv8[8];
#pragma unroll
        for (int i = 0; i < 8; ++i) { const unsigned kk = hi ? tk[8 + i] : tk[i]; gv8[i] = (hi ? ex[8 + i] : ex[i]) * inv;
            const int flat = 255 - (int)(kk & 255u), a = flat >> 4, b = flat & 15;
            ev[i] = LST[r32 * 32 + a] * NKEY + LST[r32 * 32 + 16 + b]; }
        { typedef int i32x4v __attribute__((ext_vector_type(4)));
          *(GAS i32x4v*)eo = (i32x4v){ev[0], ev[1], ev[2], ev[3]}; *(GAS i32x4v*)(eo + 4) = (i32x4v){ev[4], ev[5], ev[6], ev[7]};
          *(GAS f32x4*)go = (f32x4){gv8[0], gv8[1], gv8[2], gv8[3]}; *(GAS f32x4*)(go + 4) = (f32x4){gv8[4], gv8[5], gv8[6], gv8[7]}; }
        asm volatile("s_waitcnt lgkmcnt(0)" ::: "memory");
    }
}

__device__ __forceinline__ float gelu_exact(float a) { return 0.5f * a * (1.0f + erff(a * 0.70710678118654752f)); }
typedef _Float16 h2v __attribute__((ext_vector_type(2)));
__device__ __forceinline__ int dpp_addi(int v, int which) {
    int m;
    if (which == 0) m = __builtin_amdgcn_update_dpp(0, v, 0xB1, 0xF, 0xF, false);
    else if (which == 1) m = __builtin_amdgcn_update_dpp(0, v, 0x4E, 0xF, 0xF, false);
    else if (which == 2) m = __builtin_amdgcn_update_dpp(0, v, 0x141, 0xF, 0xF, false);
    else m = __builtin_amdgcn_update_dpp(0, v, 0x140, 0xF, 0xF, false);
    return v + m;
}
__device__ __forceinline__ int wave_sumi(int v) {
#pragma unroll
    for (int o = 1; o < 64; o <<= 1) v += __shfl_xor(v, o);
    return v;
}
constexpr float ACC_SCALE = 64.f;
__device__ __forceinline__ void p9_peer_final(Frame& F) {
    const int gw = F.vcu * NWAVES + F.wave, NGW = F.G * NWAVES, lane = F.lane;
    const float* nfp = F_IN(15);
    for (int t = gw; t < M; t += NGW) {
        const int e0 = F_EIDX[(size_t)t * NSLOT + lane], e1 = F_EIDX[(size_t)t * NSLOT + 64 + lane];
        const float gt0 = F_EG[(size_t)t * NSLOT + lane], gt1 = F_EG[(size_t)t * NSLOT + 64 + lane];
        int xlo[2][4], xhi[2][4]; int csum = 0; const float sx = 1.0f / HQ_SCALE;
#pragma unroll
        for (int c2 = 0; c2 < 2; ++c2)
#pragma unroll
            for (int m = 0; m < 4; ++m) { const unsigned d0 = *(const GAS unsigned*)(F_HQ8 + (size_t)t * DM + c2 * 2048 + (2 * m) * 256 + lane * 4), d1 = *(const GAS unsigned*)(F_HQ8 + (size_t)t * DM + c2 * 2048 + (2 * m + 1) * 256 + lane * 4);
                xlo[c2][m] = (int)((d0 & 0xFFu) | ((d0 >> 8) & 0xFF00u) | ((d1 & 0xFFu) << 16) | ((d1 << 8) & 0xFF000000u));
                xhi[c2][m] = (int)(((d0 >> 8) & 0xFFu) | ((d0 >> 16) & 0xFF00u) | ((d1 << 8) & 0xFF0000u) | (d1 & 0xFF000000u));
                csum = __builtin_amdgcn_sdot4((int)d0, 0x01010101, csum, false); csum = __builtin_amdgcn_sdot4((int)d1, 0x01010101, csum, false); }
        const float ctot = (float)wave_sumi(csum);
        unsigned XL[2][4], XH[2][4];
#pragma unroll
        for (int c2 = 0; c2 < 2; ++c2)
#pragma unroll
            for (int m = 0; m < 4; ++m) { const unsigned lo_ = (unsigned)xlo[c2][m], hi_ = (unsigned)xhi[c2][m];
                XL[c2][m] = (lo_ & 0x0F0F0F0Fu) | ((hi_ & 0x0F0F0F0Fu) << 4); XH[c2][m] = (((lo_ >> 4) & 0x0F0F0F0Fu) | (hi_ & 0xF0F0F0F0u)) ^ 0x88888888u; }
        float a0 = 0.f, a1 = 0.f;
#define P9_SLOT_E(s_) __builtin_amdgcn_readlane((s_) < 64 ? e0 : e1, (s_) & 63)
#define P9_LOADG(buf, TAB, g) do { _Pragma("unroll") for (int r_ = 0; r_ < 4; ++r_) { const int e_ = P9_SLOT_E(4 * (g) + r_); \
            const GAS v4u* p_ = (const GAS v4u*)((TAB) + (size_t)e_ * (DM / 2)) + lane; buf[r_][0] = p_[0]; buf[r_][1] = p_[64]; } } while (0)
#define P9_DOTG(buf, g) do { int sr[4]; \
            _Pragma("unroll") for (int r_ = 0; r_ < 4; ++r_) { unsigned sl_ = 0u, sh_ = 0u, sn_ = 0u; \
                _Pragma("unroll") for (int c2 = 0; c2 < 2; ++c2) _Pragma("unroll") for (int m = 0; m < 4; ++m) { const unsigned w = buf[r_][c2][m]; \
                    sl_ = __builtin_amdgcn_udot8(w, XL[c2][m], sl_, false); sh_ = __builtin_amdgcn_udot8(w, XH[c2][m], sh_, false); sn_ = __builtin_amdgcn_udot8(w, 0x11111111u, sn_, false); } \
                int s_ = 16 * ((int)sh_ - 8 * (int)sn_) + (int)sl_;                            \
                s_ = dpp_addi(s_, 0); s_ = dpp_addi(s_, 1); s_ = dpp_addi(s_, 2); s_ = dpp_addi(s_, 3); sr[r_] = s_; } \
            int v_ = (lane & 2) ? ((lane & 1) ? sr[3] : sr[2]) : ((lane & 1) ? sr[1] : sr[0]); \
            v_ += __shfl_xor(v_, 16); v_ += __shfl_xor(v_, 32); \
            _Pragma("unroll") for (int r_ = 0; r_ < 4; ++r_) { const int s_ = 4 * (g) + r_; const float tot_ = (float)__builtin_amdgcn_readlane(v_, r_); \
                if (lane == (s_ & 63)) { if (s_ < 64) a0 = tot_; else a1 = tot_; } } } while (0)
        for (int urep_ = 0; urep_ < (P9_DUP_PART == 1 ? 2 : 1); ++urep_)
        { v4u wA[4][2], wB[4][2], wC[4][2];
          P9_LOADG(wA, F_U4, 0); P9_LOADG(wB, F_U4, 1);
#pragma unroll 1
          for (int g = 0; g < 30; g += 3) {
              P9_LOADG(wC, F_U4, g + 2); P9_DOTG(wA, g);
              P9_LOADG(wA, F_U4, g + 3); P9_DOTG(wB, g + 1);
              P9_LOADG(wB, F_U4, g + 4); P9_DOTG(wC, g + 2);
          }
          P9_DOTG(wA, 30); P9_DOTG(wB, 31); }
#ifdef DBG_NO_PEER
        const float act0 = 0.f * a0 * gt0, act1 = 0.f * a1 * gt1;
#else
        const float ua = U_STEP * sx * (1.0f / sqrtf(__hip_atomic_load(F_ROWSS + t, __ATOMIC_RELAXED, __HIP_MEMORY_SCOPE_AGENT) * (1.0f / DM) + NORM_EPS));
        const float act0 = gelu_exact((a0 - 7.5f * ctot) * ua) * gt0, act1 = gelu_exact((a1 - 7.5f * ctot) * ua) * gt1;
#endif
#define FP4_UNPACK(w, lo0, hi0, lo1, hi1) const h2v lo0 = __builtin_amdgcn_cvt_scalef32_pk_f16_fp4(w, 1.0f, 0), hi0 = __builtin_amdgcn_cvt_scalef32_pk_f16_fp4(w, 1.0f, 1), \
                                                   lo1 = __builtin_amdgcn_cvt_scalef32_pk_f16_fp4(w, 1.0f, 2), hi1 = __builtin_amdgcn_cvt_scalef32_pk_f16_fp4(w, 1.0f, 3)
        h2v acc[2][8][2];
#pragma unroll
        for (int c2 = 0; c2 < 2; ++c2)
#pragma unroll
            for (int j = 0; j < 8; ++j) { acc[c2][j][0] = (h2v){(_Float16)0.f, (_Float16)0.f}; acc[c2][j][1] = (h2v){(_Float16)0.f, (_Float16)0.f}; }
#define P9_ACCG(buf, g) do { _Pragma("unroll") for (int r_ = 0; r_ < 4; ++r_) { const int s_ = 4 * (g) + r_; const _Float16 wt_ = (_Float16)((ACC_SCALE / V_SCALE / P9_VALU_REPS) * __uint_as_float(__builtin_amdgcn_readlane(__float_as_uint(s_ < 64 ? act0 : act1), s_ & 63))); const h2v gg = (h2v){wt_, wt_}; \
                _Pragma("unroll") for (int c2 = 0; c2 < 2; ++c2) _Pragma("unroll") for (int m = 0; m < 4; ++m) { _Pragma("unroll") for (int vd_ = 0; vd_ < P9_VALU_REPS; ++vd_) { unsigned w = buf[r_][c2][m]; if (P9_VALU_REPS > 1) asm volatile("" : "+v"(w)); FP4_UNPACK(w, l0, h0, l1, h1); \
                    acc[c2][2 * m][0] = gg * l0 + acc[c2][2 * m][0]; acc[c2][2 * m][1] = gg * h0 + acc[c2][2 * m][1]; acc[c2][2 * m + 1][0] = gg * l1 + acc[c2][2 * m + 1][0]; acc[c2][2 * m + 1][1] = gg * h1 + acc[c2][2 * m + 1][1]; } } } } while (0)
        for (int vrep_ = 0; vrep_ < (P9_DUP_PART == 2 ? 2 : 1); ++vrep_) {
#pragma unroll
        for (int c2 = 0; c2 < 2; ++c2)
#pragma unroll
            for (int j = 0; j < 8; ++j) { acc[c2][j][0] = (h2v){(_Float16)0.f, (_Float16)0.f}; acc[c2][j][1] = (h2v){(_Float16)0.f, (_Float16)0.f}; }
        { v4u wA[4][2], wB[4][2], wC[4][2];
          P9_LOADG(wA, F_V4, 0); P9_LOADG(wB, F_V4, 1);
#pragma unroll 1
          for (int g = 0; g < 30; g += 3) {
              P9_LOADG(wC, F_V4, g + 2); P9_ACCG(wA, g);
              P9_LOADG(wA, F_V4, g + 3); P9_ACCG(wB, g + 1);
              P9_LOADG(wB, F_V4, g + 4); P9_ACCG(wC, g + 2);
          }
          P9_ACCG(wA, 30); P9_ACCG(wB, 31); } }
#undef FP4_UNPACK
#undef P9_SLOT_E
#undef P9_LOADG
#undef P9_DOTG
#undef P9_ACCG
        float hs[2][8][4]; float ss = 0.f;
#pragma unroll
        for (int c2 = 0; c2 < 2; ++c2)
#pragma unroll
            for (int j = 0; j < 8; ++j) { const v2u hw_ = *(const GAS v2u*)((const bf16*)F_H1 + (size_t)t * DM + c2 * 2048 + j * 256 + lane * 4); const f32x4 hv = {bflo(hw_.x), bfhi(hw_.x), bflo(hw_.y), bfhi(hw_.y)};
                hs[c2][j][0] = hv[0] + (float)acc[c2][j][0].x * (1.0f / ACC_SCALE); hs[c2][j][1] = hv[1] + (float)acc[c2][j][0].y * (1.0f / ACC_SCALE);
                hs[c2][j][2] = hv[2] + (float)acc[c2][j][1].x * (1.0f / ACC_SCALE); hs[c2][j][3] = hv[3] + (float)acc[c2][j][1].y * (1.0f / ACC_SCALE);
#pragma unroll
                for (int q = 0; q < 4; ++q) ss += hs[c2][j][q] * hs[c2][j][q]; }
        const float r = 1.0f / sqrtf(wave_sum(ss) * (1.0f / DM) + NORM_EPS);
#pragma unroll
        for (int c2 = 0; c2 < 2; ++c2)
#pragma unroll
            for (int j = 0; j < 8; ++j) { const f32x4 g = *(const GAS f32x4*)(nfp + c2 * 2048 + j * 256 + lane * 4);
                *(GAS f32x4*)(F.out + (size_t)t * DM + c2 * 2048 + j * 256 + lane * 4) = (f32x4){hs[c2][j][0] * r * g[0], hs[c2][j][1] * r * g[1], hs[c2][j][2] * r * g[2], hs[c2][j][3] * r * g[3]}; }
    }
}

#if PEER_SLICED

constexpr size_t WS_PART = WS_END;
constexpr size_t WS_Y16 = WS_PART + 32 * MiB;
constexpr size_t WS_END2 = WS_Y16 + 64 * MiB;
#define F_PART ((int*)(F.ws + WS_PART))
#define F_Y16 ((_Float16*)(F.ws + WS_Y16))
constexpr size_t SUB_BYTES = (size_t)NEXP * 128;
__device__ __forceinline__ void p0_tables(Frame& F, LAS unsigned* scr) {
    const int gw = F.vcu * NWAVES + F.wave, NGW = F.G * NWAVES, lane = F.lane, odd = lane & 1;
    constexpr int NCH = NEXP * 2;
    for (int cidx = gw; cidx < 2 * NCH; cidx += NGW) {
        const bool isu = cidx < NCH; const int cc = isu ? cidx : cidx - NCH, e = cc >> 1, hh = cc & 1;
        const GAS f32x4* src = (const GAS f32x4*)((isu ? F_IN(13) : F_IN(14)) + (size_t)cc * 2048) + lane;
        f32x4 a[8];
#pragma unroll
        for (int j = 0; j < 8; ++j) a[j] = src[j * 64];
#pragma unroll
        for (int j = 0; j < 8; ++j) { unsigned piece;
            if (isu) { piece = 0u;
#pragma unroll
                for (int q = 0; q < 4; ++q) { int n = (int)floorf(a[j][q] * (1.0f / U_STEP)) + 8; n = n < 0 ? 0 : (n > 15 ? 15 : n); piece |= (unsigned)n << (8 * q); }
                piece <<= 4 * odd;
            } else { unsigned we = 0u, wo = 0u; const float v0 = a[j].x * V_SCALE, v1 = a[j].y * V_SCALE, v2 = a[j].z * V_SCALE, v3 = a[j].w * V_SCALE;
                we = __builtin_amdgcn_cvt_scalef32_pk_fp4_f32(we, v0, v1, 1.0f, 0); we = __builtin_amdgcn_cvt_scalef32_pk_fp4_f32(we, v2, v3, 1.0f, 1);
                wo = __builtin_amdgcn_cvt_scalef32_pk_fp4_f32(wo, v0, v1, 1.0f, 2); wo = __builtin_amdgcn_cvt_scalef32_pk_fp4_f32(wo, v2, v3, 1.0f, 3);
                piece = odd ? wo : we; }
            const unsigned full = piece | (unsigned)__builtin_amdgcn_update_dpp(0, (int)piece, 0xB1, 0xF, 0xF, false);
            if (!odd) scr[j * 32 + (lane >> 1)] = full; }
        LDS_WAIT(); asm volatile("" ::: "memory");
        const v4u o = *(const LAS v4u*)(scr + lane * 4);
        LDS_WAIT(); asm volatile("" ::: "memory");
        unsigned char* dst = (isu ? F_U4 : F_V4) + (size_t)(8 * hh + (lane >> 3)) * SUB_BYTES + (size_t)e * 128 + (lane & 7) * 16;
        *(GAS v4u*)dst = o;
    }
}

__device__ __forceinline__ void p9a_udot(Frame& F) {
    const int R = F.G >> 3, k = F.vcu / R, rank = F.vcu % R, lane = F.lane, wave = F.wave, c = lane & 7, g8 = lane >> 3;
    LAS int* aP = (LAS int*)F.lds;
    for (int tb = rank * 256; tb < M; tb += R * 256) {
        for (int i = F.tid; i < 256 * 128; i += NTHR) aP[i] = 0;
        __syncthreads();
        const int tw = tb + wave * 32;
#define A_TOK(n) (tw + ((n) & 31))
#define A_SUB(n) (2 * k + ((n) >> 5))
#define A_E(n, E0, E1) do { E0 = F_EIDX[(size_t)A_TOK(n) * NSLOT + lane]; E1 = F_EIDX[(size_t)A_TOK(n) * NSLOT + 64 + lane]; } while (0)
#define A_X(n, XA, XB) do { const GAS v4u* xp_ = (const GAS v4u*)(F_HQ8 + (size_t)A_TOK(n) * DM + 256 * A_SUB(n) + 32 * c); XA = xp_[0]; XB = xp_[1]; } while (0)
#define A_G(n, E0, E1, W) do { const unsigned char* tb_ = F_U4 + (size_t)A_SUB(n) * SUB_BYTES + c * 16; \
            _Pragma("unroll") for (int ii = 0; ii < 16; ++ii) { const int el = __shfl(ii < 8 ? E0 : E1, 8 * (ii & 7) + g8); W[ii] = *(const GAS v4u*)(tb_ + (size_t)el * 128); } } while (0)
#define A_C(n, XA, XB, W) do { const int xlo[4] = {(int)XA.x, (int)XA.z, (int)XB.x, (int)XB.z}, xhi[4] = {(int)XA.y, (int)XA.w, (int)XB.y, (int)XB.w}; const int tl_ = wave * 32 + ((n) & 31); \
            _Pragma("unroll") for (int ii = 0; ii < 16; ++ii) { int s_ = 0; \
                _Pragma("unroll") for (int m = 0; m < 4; ++m) { const unsigned wd = W[ii][m]; \
                    s_ = __builtin_amdgcn_sdot4((int)(wd & 0x0F0F0F0Fu), xlo[m], s_, false); s_ = __builtin_amdgcn_sdot4((int)((wd >> 4) & 0x0F0F0F0Fu), xhi[m], s_, false); } \
                s_ = dpp_addi(s_, 0); s_ = dpp_addi(s_, 1); s_ = dpp_addi(s_, 2); \
                if (c == 0) __hip_atomic_fetch_add(aP + tl_ * 128 + 8 * ii + g8, s_, __ATOMIC_RELAXED, __HIP_MEMORY_SCOPE_WORKGROUP); } } while (0)
        int eA0, eA1, eB0, eB1; v4u xA0, xA1, xB0, xB1, wA[16], wB[16];
        A_E(0, eA0, eA1); A_E(1, eB0, eB1); A_G(0, eA0, eA1, wA); A_X(0, xA0, xA1);
#pragma unroll 1
        for (int n = 0; n < 64; n += 2) {
            if (n + 2 < 64) A_E(n + 2, eA0, eA1); A_G(n + 1, eB0, eB1, wB); A_X(n + 1, xB0, xB1);
            A_C(n, xA0, xA1, wA);
            if (n + 3 < 64) A_E(n + 3, eB0, eB1); if (n + 2 < 64) { A_G(n + 2, eA0, eA1, wA); A_X(n + 2, xA0, xA1); }
            A_C(n + 1, xB0, xB1, wB);
        }
#undef A_TOK
#undef A_SUB
#undef A_E
#undef A_X
#undef A_G
#undef A_C
        __syncthreads();
        { GAS v4u* dst = (GAS v4u*)(F_PART + ((size_t)k * M + tb) * NSLOT);
          for (int i = F.tid; i < 256 * 128 / 4; i += NTHR) dst[i] = *(const LAS v4u*)(aP + 4 * i); }
        __syncthreads();
    }
}

__device__ __forceinline__ void p9b_vsum(Frame& F) {
    const int R = F.G >> 3, k = F.vcu / R, rank = F.vcu % R, lane = F.lane, wave = F.wave, c = lane & 7, g8 = lane >> 3;
    LAS _Float16* actL = (LAS _Float16*)F.lds;
    for (int tb = rank * 256; tb < M; tb += R * 256) {
        const int tw = tb + wave * 32;
#pragma unroll 1
        for (int i4 = 0; i4 < 32; i4 += 4) { int s0[4], s1[4]; float sxv[4], g0[4], g1[4]; int csv[4];
#pragma unroll
            for (int u = 0; u < 4; ++u) { const int tok = tw + i4 + u; s0[u] = 0; s1[u] = 0;
#pragma unroll
                for (int kk = 0; kk < 8; ++kk) { s0[u] += F_PART[((size_t)kk * M + tok) * NSLOT + lane]; s1[u] += F_PART[((size_t)kk * M + tok) * NSLOT + 64 + lane]; }
                sxv[u] = (1.0f / HQ_SCALE) / sqrtf(__hip_atomic_load(F_ROWSS + tok, __ATOMIC_RELAXED, __HIP_MEMORY_SCOPE_AGENT) * (1.0f / DM) + NORM_EPS); csv[u] = __hip_atomic_load(F_ROWCS + tok, __ATOMIC_RELAXED, __HIP_MEMORY_SCOPE_AGENT); g0[u] = F_EG[(size_t)tok * NSLOT + lane]; g1[u] = F_EG[(size_t)tok * NSLOT + 64 + lane]; }
#pragma unroll
            for (int u = 0; u < 4; ++u) { const int tl = wave * 32 + i4 + u; const float ua = U_STEP * sxv[u], cb = 7.5f * (float)csv[u];
                const float act0 = gelu_exact(((float)s0[u] - cb) * ua) * g0[u] * (ACC_SCALE / V_SCALE), act1 = gelu_exact(((float)s1[u] - cb) * ua) * g1[u] * (ACC_SCALE / V_SCALE);
                actL[tl * 128 + (lane & 7) * 16 + (lane >> 3)] = (_Float16)act0;
                actL[tl * 128 + (lane & 7) * 16 + 8 + (lane >> 3)] = (_Float16)act1; } }
        LDS_WAIT(); asm volatile("" ::: "memory");
#define B_TOK(n) (tw + ((n) & 31))
#define B_SUB(n) (2 * k + ((n) >> 5))
#define B_E(n, E0, E1) do { E0 = F_EIDX[(size_t)B_TOK(n) * NSLOT + lane]; E1 = F_EIDX[(size_t)B_TOK(n) * NSLOT + 64 + lane]; } while (0)
#define B_YP(n) ((GAS v2u*)(F_Y16 + (size_t)B_TOK(n) * DM + 256 * B_SUB(n) + 32 * c + 4 * g8))
#define B_G(n, E0, E1, W) do { const unsigned char* tb_ = F_V4 + (size_t)B_SUB(n) * SUB_BYTES + c * 16; \
            _Pragma("unroll") for (int ii = 0; ii < 16; ++ii) { const int el = __shfl(ii < 8 ? E0 : E1, 8 * (ii & 7) + g8); W[ii] = *(const GAS v4u*)(tb_ + (size_t)el * 128); } } while (0)
#define B_C(n, W) do { const int tl_ = wave * 32 + ((n) & 31); \
            const v4u wq0 = *(const LAS v4u*)(actL + tl_ * 128 + g8 * 16), wq1 = *(const LAS v4u*)(actL + tl_ * 128 + g8 * 16 + 8); \
            h2v acc[4][4]; \
            _Pragma("unroll") for (int m = 0; m < 4; ++m) _Pragma("unroll") for (int b = 0; b < 4; ++b) acc[m][b] = (h2v){(_Float16)0.f, (_Float16)0.f}; \
            _Pragma("unroll") for (int ii = 0; ii < 16; ++ii) { const unsigned wp = ii < 8 ? wq0[ii >> 1] : wq1[(ii - 8) >> 1]; const h2v wpair = __builtin_bit_cast(h2v, wp); \
                const _Float16 wt = (ii & 1) ? wpair.y : wpair.x; const h2v gg = (h2v){wt, wt}; \
                _Pragma("unroll") for (int m = 0; m < 4; ++m) { const unsigned wd = W[ii][m]; \
                    acc[m][0] = gg * __builtin_amdgcn_cvt_scalef32_pk_f16_fp4(wd, 1.0f, 0) + acc[m][0]; acc[m][1] = gg * __builtin_amdgcn_cvt_scalef32_pk_f16_fp4(wd, 1.0f, 1) + acc[m][1]; \
                    acc[m][2] = gg * __builtin_amdgcn_cvt_scalef32_pk_f16_fp4(wd, 1.0f, 2) + acc[m][2]; acc[m][3] = gg * __builtin_amdgcn_cvt_scalef32_pk_f16_fp4(wd, 1.0f, 3) + acc[m][3]; } } \
            _Pragma("unroll") for (int m = 0; m < 4; ++m) _Pragma("unroll") for (int b = 0; b < 4; ++b) { const int bits = __builtin_bit_cast(int, acc[m][b]); \
                h2v t = acc[m][b] + __builtin_bit_cast(h2v, __builtin_amdgcn_update_dpp(0, bits, 0x128, 0xF, 0xF, false)); \
                t = t + __builtin_bit_cast(h2v, __shfl_xor(__builtin_bit_cast(int, t), 16)); \
                { const unsigned tb2_ = __builtin_bit_cast(unsigned, t); auto rr_ = __builtin_amdgcn_permlane32_swap(tb2_, tb2_, false, false); t = __builtin_bit_cast(h2v, (unsigned)rr_[0]) + __builtin_bit_cast(h2v, (unsigned)rr_[1]); } acc[m][b] = t; } \
            h2v o0 = acc[0][0], o1 = acc[0][1]; \
            _Pragma("unroll") for (int gg8 = 1; gg8 < 8; ++gg8) { if (g8 == gg8) { o0 = acc[gg8 >> 1][2 * (gg8 & 1)]; o1 = acc[gg8 >> 1][2 * (gg8 & 1) + 1]; } } \
            v2u yo_; yo_.x = __builtin_bit_cast(unsigned, o0); yo_.y = __builtin_bit_cast(unsigned, o1); *B_YP(n) = yo_; } while (0)
        int eA0, eA1, eB0, eB1; v4u wA[16], wB[16];
        B_E(0, eA0, eA1); B_E(1, eB0, eB1); B_G(0, eA0, eA1, wA);
#pragma unroll 1
        for (int n = 0; n < 64; n += 2) {
            if (n + 2 < 64) B_E(n + 2, eA0, eA1); B_G(n + 1, eB0, eB1, wB);
            B_C(n, wA);
            if (n + 3 < 64) B_E(n + 3, eB0, eB1); if (n + 2 < 64) B_G(n + 2, eA0, eA1, wA);
            B_C(n + 1, wB);
        }
#undef B_TOK
#undef B_SUB
#undef B_E
#undef B_YP
#undef B_G
#undef B_C
        LDS_WAIT(); asm volatile("" ::: "memory");
    }
}

__device__ __forceinline__ void p9c_final(Frame& F) {
    const int gw = F.vcu * NWAVES + F.wave, NGW = F.G * NWAVES, lane = F.lane;
    for (int m = gw; m < M; m += NGW) {
        const GAS f32x4* xr = (const GAS f32x4*)(F_H1 + (size_t)m * DM) + lane; const GAS f32x4* gr = (const GAS f32x4*)F_IN(15) + lane; GAS f32x4* orow = (GAS f32x4*)(F.out + (size_t)m * DM) + lane; const GAS v2u* yr = (const GAS v2u*)(F_Y16 + (size_t)m * DM) + lane;
        f32x4 v[16]; float s = 0.f;
#pragma unroll
        for (int j = 0; j < 16; ++j) { v[j] = xr[64 * j]; const v2u yw = yr[64 * j]; const unsigned yw0 = yw.x, yw1 = yw.y; const h2v y0 = __builtin_bit_cast(h2v, yw0), y1 = __builtin_bit_cast(h2v, yw1);
            v[j].x += (float)y0.x * (1.0f / ACC_SCALE); v[j].y += (float)y0.y * (1.0f / ACC_SCALE); v[j].z += (float)y1.x * (1.0f / ACC_SCALE); v[j].w += (float)y1.y * (1.0f / ACC_SCALE);
            s += (v[j].x * v[j].x + v[j].y * v[j].y) + (v[j].z * v[j].z + v[j].w * v[j].w); }
        const float r = 1.0f / sqrtf(wave_sum(s) * (1.0f / DM) + NORM_EPS);
#pragma unroll
        for (int j = 0; j < 16; ++j) { const f32x4 g = gr[64 * j]; orow[64 * j] = (f32x4){v[j].x * r * g.x, v[j].y * r * g.y, v[j].z * r * g.z, v[j].w * r * g.w}; }
    }
}

#endif
struct Args { const float* in[16]; float* out; unsigned char* ws; int ph_lo, ph_hi; };
__global__ void __launch_bounds__(NTHR, 2) fwd(Args args) {
    extern __shared__ __attribute__((aligned(16))) unsigned char lds[];
    Frame F;
    F.lds = (LAS unsigned char*)lds;
    F.tid = threadIdx.x; F.lane = F.tid & 63; F.wave = __builtin_amdgcn_readfirstlane(F.tid >> 6);
    F.G = gridDim.x; { const int bx = blockIdx.x; F.vcu = (F.G % 8 == 0) ? (bx % 8) * (F.G / 8) + bx / 8 : bx; }
    unsigned char* ws = args.ws;
    F.out = args.out;
    F.ws = ws;
    for (int u = F.tid; u < (LDS_BYTES - LDSCTL_OFF) / 4; u += NTHR) ((LAS unsigned*)(F.lds + LDSCTL_OFF))[u] = 0u;
    __syncthreads();
    if (F.tid == 0) { volatile LAS unsigned* ip = (volatile LAS unsigned*)(F.lds + LDSCTL_OFF + 128);
        ip[0] = (unsigned)(unsigned long long)args.in[0]; ip[1] = (unsigned)((unsigned long long)args.in[0] >> 32);
        ip[2] = (unsigned)(unsigned long long)args.in[1]; ip[3] = (unsigned)((unsigned long long)args.in[1] >> 32);
        ip[4] = (unsigned)(unsigned long long)args.in[2]; ip[5] = (unsigned)((unsigned long long)args.in[2] >> 32);
        ip[6] = (unsigned)(unsigned long long)args.in[3]; ip[7] = (unsigned)((unsigned long long)args.in[3] >> 32);
        ip[8] = (unsigned)(unsigned long long)args.in[4]; ip[9] = (unsigned)((unsigned long long)args.in[4] >> 32);
        ip[10] = (unsigned)(unsigned long long)args.in[5]; ip[11] = (unsigned)((unsigned long long)args.in[5] >> 32);
        ip[12] = (unsigned)(unsigned long long)args.in[6]; ip[13] = (unsigned)((unsigned long long)args.in[6] >> 32);
        ip[14] = (unsigned)(unsigned long long)args.in[7]; ip[15] = (unsigned)((unsigned long long)args.in[7] >> 32);
        ip[16] = (unsigned)(unsigned long long)args.in[8]; ip[17] = (unsigned)((unsigned long long)args.in[8] >> 32);
        ip[18] = (unsigned)(unsigned long long)args.in[9]; ip[19] = (unsigned)((unsigned long long)args.in[9] >> 32);
        ip[20] = (unsigned)(unsigned long long)args.in[10]; ip[21] = (unsigned)((unsigned long long)args.in[10] >> 32);
        ip[22] = (unsigned)(unsigned long long)args.in[11]; ip[23] = (unsigned)((unsigned long long)args.in[11] >> 32);
        ip[24] = (unsigned)(unsigned long long)args.in[12]; ip[25] = (unsigned)((unsigned long long)args.in[12] >> 32);
        ip[26] = (unsigned)(unsigned long long)args.in[13]; ip[27] = (unsigned)((unsigned long long)args.in[13] >> 32);
        ip[28] = (unsigned)(unsigned long long)args.in[14]; ip[29] = (unsigned)((unsigned long long)args.in[14] >> 32);
        ip[30] = (unsigned)(unsigned long long)args.in[15]; ip[31] = (unsigned)((unsigned long long)args.in[15] >> 32);
    }
    __syncthreads();
    unsigned* barw = (unsigned*)(ws + WS_CTL) + CW_BAR;
    XcdBarrier bar; bar.bar = barw; bar.x = 0; bar.st = nullptr;
    if (N_LAUNCHES == 1) bar = xcd_barrier_post(barw, (volatile LAS unsigned*)(F.lds + LDSCTL_OFF));
    const int lo = args.ph_lo, hi = args.ph_hi;
#define IN(k) (lo <= (k) && (k) < hi)
#define SEAM(k) do { if (IN(k) && IN((k) + 1)) xcd_barrier(bar); } while (0)
    LAS unsigned char* ring = F.lds;

    if (((PHASE_MASK >> 0) & 1) && IN(0)) { for (int rep_ = 0; rep_ < (DUP_PHASE == 0 ? 2 : 1); ++rep_) { p0_prologue(F); } SEAM(0); }
    if (((PHASE_MASK >> 1) & 1) && IN(1)) { for (int rep_ = 0; rep_ < (DUP_PHASE == 1 ? 2 : 1); ++rep_) {
        { pg8::Gemm g{F_HN, F_WT_IN, M, NGATE0, DM}; pg8::StaticOrder S; S.init(M, NGATE0, F.G, (int)blockIdx.x, GDUP(0));
          pg8::EpiSplitBf16 E{F_PROJ, AW, AW, PROJ_TS, SLABS_BF16};
          pg8::gemm_phase<pg8::EpiSplitBf16, pg8::StaticOrder, true, true>(ring, g, S, E); }
        { pg8::Gemm g{(const bf16*)F_HN8, (const bf16*)F_W8T, M, NPROJ - NGATE0, DM / 2}; pg8::StaticOrder S; S.init(M, NPROJ - NGATE0, F.G, (int)blockIdx.x, GDUP(1));
          pg8::EpiI8Split E{F_PROJ, AW, AW, PROJ_TS, F_SX, 1.0f / W8_SCALE, SLABS_I8};
          pg8::gemm_phase<pg8::EpiI8Split, pg8::StaticOrder, true, true, true>(ring, g, S, E); }
        } SEAM(1);
    }
    if (((PHASE_MASK >> 2) & 1) && IN(2)) { for (int rep_ = 0; rep_ < (DUP_PHASE == 2 ? 2 : 1); ++rep_) { p2_kmean_conv(F); } SEAM(2); }
    if (((PHASE_MASK >> 3) & 1) && IN(3)) { for (int rep_ = 0; rep_ < (DUP_PHASE == 3 ? 2 : 1); ++rep_) { p3_attention(F, (char*)lds); } SEAM(3); }
    if (((PHASE_MASK >> 4) & 1) && IN(4)) { for (int rep_ = 0; rep_ < (DUP_PHASE == 4 ? 2 : 1); ++rep_) {
        { pg8::Gemm g{F_ATT, F_WT_BRA, M, DM, AW / 2}; pg8::StaticOrder S; S.init(M, DM, F.G, (int)blockIdx.x, GDUP(2));
          pg8::EpiGate<false, true> E{F_MRG, DM, F_PROJ + 6 * PROJ_TS, AW, PROJ_TS, F_IN(7), 1.0f / (moba::ATT_SCALE * WB8_SCALE)};
          pg8::gemm_phase<pg8::EpiGate<false, true>, pg8::StaticOrder, true, true, true>(ring, g, S, E); }
        VM_WAIT(); __builtin_amdgcn_fence(__ATOMIC_ACQUIRE, "agent"); VM_WAIT(); __syncthreads();
        { pg8::Gemm g{F_CONV, F_WT_BRC, M, DM, AW}; pg8::StaticOrder S; S.init(M, DM, F.G, (int)blockIdx.x);
          pg8::EpiGate<true> E{F_MRG, DM, F_PROJ + 8 * PROJ_TS, AW, PROJ_TS, F_IN(7) + DM};
          pg8::gemm_phase<pg8::EpiGate<true>, pg8::StaticOrder, true, true>(ring, g, S, E); }
        } SEAM(4);
    }
    if (((PHASE_MASK >> 5) & 1) && IN(5)) { for (int rep_ = 0; rep_ < (DUP_PHASE == 5 ? 2 : 1); ++rep_) {
        pg8::Gemm g{F_MRG, F_WT_OUT, M, DM, DM}; pg8::StaticOrder S; S.init(M, DM, F.G, (int)blockIdx.x);
        pg8::EpiResNormStat E{F_H1, F_IN(0), DM, F_HQ8, F_IN(10), F_ROWSS, HQ_SCALE, PEER_SLICED ? F_ROWCS : nullptr};
        pg8::gemm_phase<pg8::EpiResNormStat, pg8::StaticOrder, true, true>(ring, g, S, E);
        } SEAM(5);
    }
    if (((PHASE_MASK >> 7) & 1) && IN(7)) { for (int rep_ = 0; rep_ < (DUP_PHASE == 7 ? 2 : 1); ++rep_) {
        pg8::Gemm g{(const bf16*)F_HQ8, (const bf16*)F_WPQ8, M, PQW, DM / 2}; pg8::StaticOrder S; S.init(M, PQW, F.G, (int)blockIdx.x, GDUP(4));
        pg8::EpiHiLoI8 E{F_QH, nullptr, PQW, F_ROWSS, 1.0f / DM, NORM_EPS, 1.0f / (HQ_SCALE * W8_SCALE)};
        pg8::gemm_phase<pg8::EpiHiLoI8, pg8::StaticOrder, true, true, true>(ring, g, S, E);
        } SEAM(7);
    }
    if (((PHASE_MASK >> 8) & 1) && IN(8)) { for (int rep_ = 0; rep_ < (DUP_PHASE == 8 ? 2 : 1); ++rep_) { p8_peer_topk(F); } SEAM(8); }
#if PEER_SLICED
    if (((PHASE_MASK >> 9) & 1) && IN(9)) { for (int rep_ = 0; rep_ < (DUP_PHASE == 9 ? 2 : 1); ++rep_) { p9a_udot(F); } SEAM(9); }
    if (((PHASE_MASK >> 10) & 1) && IN(10)) { for (int rep_ = 0; rep_ < (DUP_PHASE == 10 ? 2 : 1); ++rep_) { p9b_vsum(F); } SEAM(10); }
    if (((PHASE_MASK >> 11) & 1) && IN(11)) { for (int rep_ = 0; rep_ < (DUP_PHASE == 11 ? 2 : 1); ++rep_) { p9c_final(F); } }
#else
    if (((PHASE_MASK >> 9) & 1) && IN(9)) { for (int rep_ = 0; rep_ < (DUP_PHASE == 9 ? 2 : 1); ++rep_) { p9_peer_final(F); } }
#endif
#undef IN
#undef SEAM
}

extern "C" void kernel_launch(void* const* d_in, const int* in_sizes, int n_in, void* d_out, int out_size, void* d_ws, size_t ws_size, hipStream_t stream) {
    static int grid = 0;
    if (grid == 0) {
        if (n_in != 16 || in_sizes[0] != M * DM || out_size != M * DM || ws_size < WS_END + (PEER_SLICED ? 96 * MiB : 0)) { fprintf(stderr, "kernel_launch: unexpected shapes (n_in %d, in0 %d, out %d, ws %zu < %zu)\n", n_in, n_in > 0 ? in_sizes[0] : -1, out_size, ws_size, (size_t)WS_END); grid = -1; return; }
        int dev = 0, cus = 0, per_cu = 0;
        if (hipGetDevice(&dev) != hipSuccess || hipDeviceGetAttribute(&cus, hipDeviceAttributeMultiprocessorCount, dev) != hipSuccess) { grid = -1; return; }
        if (hipFuncSetAttribute((const void*)fwd, hipFuncAttributeMaxDynamicSharedMemorySize, LDS_BYTES) != hipSuccess) { fprintf(stderr, "kernel_launch: hipFuncSetAttribute failed\n"); grid = -1; return; }
        if (hipOccupancyMaxActiveBlocksPerMultiprocessor(&per_cu, (const void*)fwd, NTHR, LDS_BYTES) != hipSuccess || per_cu < 1) { fprintf(stderr, "kernel_launch: occupancy query says %d blocks per CU\n", per_cu); }
        (void)hipGetLastError();
        grid = cus;
    }
    if (grid < 0) return;
    if (hipMemsetAsync((char*)d_ws + WS_CTL, 0, CTL_ZERO_BYTES, stream) != hipSuccess) return;
    Args a{};
    for (int i = 0; i < 16; ++i) a.in[i] = (const float*)d_in[i];
    a.out = (float*)d_out; a.ws = (unsigned char*)d_ws;
    for (int li = 0; li < N_LAUNCHES; ++li) {
        a.ph_lo = (N_LAUNCHES == 1) ? 0 : li; a.ph_hi = (N_LAUNCHES == 1) ? N_PHASES : li + 1;
        hipLaunchKernelGGL(fwd, dim3(grid), dim3(NTHR), LDS_BYTES, stream, a);
        if (hipPeekAtLastError() != hipSuccess) { fprintf(stderr, "kernel_launch: launch %d failed\n", li); break; }
    }
}
```

```cpp
#include <hip/hip_runtime.h>
#include <cstdio>
#include <cstdint>
#define PEER_SLICED 0
namespace pg8 {
#define PG8_LAS __attribute__((address_space(3)))
typedef unsigned short bf16_t;
typedef short bf16x8 __attribute__((ext_vector_type(8)));
typedef float f32x4 __attribute__((ext_vector_type(4)));
typedef unsigned u32x4 __attribute__((ext_vector_type(4)));
constexpr int BM = 256, BK = 64, HALF = 128, HTB = HALF * BK * 2  , STAGE_BYTES = 8 * HTB, NXCD = 8, WGM = 2;

__host__ __device__ __forceinline__ int lds_byte(int r, int c) { const int st = (r >> 4) * 2 + (c >> 5), rr = r & 15, cc = c & 31, ob = rr * 64 + cc * 2; return st * 1024 + (ob ^ (((ob >> 9) & 1) << 5)); }
__host__ __device__ __forceinline__ void stage_rc(int b, int& R, int& C) { const int st = b / 1024, sb = b % 1024, swz = sb ^ (((sb >> 9) & 1) << 5); R = (st >> 1) * 16 + swz / 64; C = (st & 1) * 32 + (swz % 64) / 2; }
__host__ __device__ __forceinline__ int perm32(int rho) { const int n = rho >> 4, i = rho & 15; return 8 * (i >> 2) + 4 * n + (i & 3); }

struct Unit { int pm, pn; };
struct Gemm { const bf16_t* A; const bf16_t* Bt; int M, N, K; };

struct StaticOrder {
    int nM, nN, nwg, G, c, reps;
    __host__ __device__ void init(int M, int N, int G_, int c_, int reps_ = 1) { nM = M / BM; nN = N / BM; nwg = nM * nN; G = G_; c = c_; reps = reps_; }
    __host__ __device__ bool next(int i, Unit& u) const {
        const long L0 = (long)i * G + c; if (L0 >= (long)nwg * reps) return false;
        const long L = L0 % nwg;
        int wgid = (int)L; { const int q = nwg / NXCD, r = nwg % NXCD, xcd = wgid % NXCD, off = wgid / NXCD; wgid = (xcd < r ? xcd * (q + 1) : r * (q + 1) + (xcd - r) * q) + off; }
        const int nig = WGM * nN, gid = wgid / nig, fm = gid * WGM, gsz = (nM - fm) < WGM ? (nM - fm) : WGM;
        u.pm = fm + ((wgid % nig) % gsz); u.pn = (wgid % nig) / gsz; return true;
    }
    __device__ __forceinline__ void a_ready(const Unit&) const {}
    __device__ __forceinline__ void done(const Unit&) const {}
};

__device__ __forceinline__ unsigned cvt_pk_bf16(float lo, float hi) { unsigned r; asm volatile("v_cvt_pk_bf16_f32 %0, %1, %2" : "=v"(r) : "v"(lo), "v"(hi)); return r; }
typedef float f32x2 __attribute__((ext_vector_type(2)));
__device__ __forceinline__ f32x2 gelu_pk(f32x2 v) {
    const f32x2 av = __builtin_elementwise_abs(v), d = av * 0.2316418882f + 1.0f;
    f32x2 t; t.x = __builtin_amdgcn_rcpf(d.x); t.y = __builtin_amdgcn_rcpf(d.y);
    f32x2 q = t * 0.5307027145f + (-0.7265760135f); q = q * t + 0.7107068705f; q = q * t + (-0.142248368f); q = q * t + 0.127414796f; q = q * t;
    const f32x2 s = (v * v) * (-0.72134752044f);
    f32x2 e; e.x = __builtin_amdgcn_exp2f(s.x); e.y = __builtin_amdgcn_exp2f(s.y);
    const f32x2 m = v * (q * e), r = v - m;
    f32x2 o; o.x = v.x < 0.f ? m.x : r.x; o.y = v.y < 0.f ? m.y : r.y; return o;
}


__device__ __forceinline__ float bf_lo(unsigned w) { return __uint_as_float(w << 16); }
__device__ __forceinline__ float bf_hi(unsigned w) { return __uint_as_float(w & 0xffff0000u); }
__device__ __forceinline__ float sigmoid_f(float x) { return __builtin_amdgcn_rcpf(1.0f + __builtin_amdgcn_exp2f(-1.4426950408889634f * x)); }

struct EpiSplitBf16 {
    static constexpr bool PERM = true, AFTER_DRAIN = false;
    bf16_t* O; int ldc; int split_cols; size_t split_stride; unsigned long long slabmap;
    __device__ __forceinline__ void operator()(const f32x4 (&acc)[2][2][4][2], const Unit& u, int wr, int wc, int fr, int fq) const {
        const int row0 = u.pm * BM + wr * 64 + fr; int colt = u.pn * BM; bf16_t* base = O;
        if (split_cols) { const int t = colt / split_cols; base += (size_t)((slabmap >> (4 * t)) & 15ull) * split_stride; colt -= t * split_cols; }
        const int col0 = colt + wc * 32 + 8 * fq;
#pragma unroll
        for (int ai = 0; ai < 2; ++ai)
#pragma unroll
            for (int m = 0; m < 4; ++m) { bf16_t* rowp = base + (size_t)(row0 + ai * HALF + m * 16) * ldc + col0;
#pragma unroll
                for (int bj = 0; bj < 2; ++bj) { const f32x4 v0 = acc[ai][bj][m][0], v1 = acc[ai][bj][m][1];
                    u32x4 w; w.x = cvt_pk_bf16(v0[0], v0[1]); w.y = cvt_pk_bf16(v0[2], v0[3]); w.z = cvt_pk_bf16(v1[0], v1[1]); w.w = cvt_pk_bf16(v1[2], v1[3]);
                    *(u32x4*)(rowp + bj * HALF) = w; } }
    }
};

template <bool ADD, bool I8ACC = false> struct EpiGate {
    static constexpr bool PERM = true, AFTER_DRAIN = false;
    bf16_t* O; int ldc; const bf16_t* G; int g_cols; size_t g_stride; const float* bg; float cs = 1.0f;
    __device__ __forceinline__ void operator()(const f32x4 (&acc)[2][2][4][2], const Unit& u, int wr, int wc, int fr, int fq) const {
        const int row0 = u.pm * BM + wr * 64 + fr, colt = u.pn * BM;
        const int gt = colt / g_cols; const bf16_t* gb = G + (size_t)gt * g_stride; const int gcol0 = colt - gt * g_cols + wc * 32 + 8 * fq;
        const int col0 = colt + wc * 32 + 8 * fq;
        f32x4 bv[2][2];
#pragma unroll
        for (int bj = 0; bj < 2; ++bj)
#pragma unroll
            for (int n = 0; n < 2; ++n) bv[bj][n] = *(const f32x4*)(bg + col0 + bj * HALF + 4 * n);
#pragma unroll
        for (int ai = 0; ai < 2; ++ai)
#pragma unroll
            for (int m = 0; m < 4; ++m) { const int r = row0 + ai * HALF + m * 16;
#pragma unroll
                for (int bj = 0; bj < 2; ++bj) {
                    const u32x4 gw = *(const u32x4*)(gb + (size_t)r * g_cols + gcol0 + bj * HALF);
                    f32x4 g0 = (f32x4){bf_lo(gw.x), bf_hi(gw.x), bf_lo(gw.y), bf_hi(gw.y)} + bv[bj][0];
                    f32x4 g1 = (f32x4){bf_lo(gw.z), bf_hi(gw.z), bf_lo(gw.w), bf_hi(gw.w)} + bv[bj][1];
                    f32x4 v0, v1;
#pragma unroll
                    for (int j = 0; j < 4; ++j) { const float a0_ = I8ACC ? (float)__float_as_int(acc[ai][bj][m][0][j]) * cs : acc[ai][bj][m][0][j], a1_ = I8ACC ? (float)__float_as_int(acc[ai][bj][m][1][j]) * cs : acc[ai][bj][m][1][j]; v0[j] = sigmoid_f(g0[j]) * a0_; v1[j] = sigmoid_f(g1[j]) * a1_; }
#ifdef DBG_NO_ATTN
                    if (!ADD) { v0 = v0 * 0.f; v1 = v1 * 0.f; }
#endif
                    bf16_t* op = O + (size_t)r * ldc + col0 + bj * HALF;
                    if (ADD) { const u32x4 ow = *(const u32x4*)op;
                        v0 += (f32x4){bf_lo(ow.x), bf_hi(ow.x), bf_lo(ow.y), bf_hi(ow.y)}; v1 += (f32x4){bf_lo(ow.z), bf_hi(ow.z), bf_lo(ow.w), bf_hi(ow.w)}; }
                    u32x4 w; w.x = cvt_pk_bf16(v0[0], v0[1]); w.y = cvt_pk_bf16(v0[2], v0[3]); w.z = cvt_pk_bf16(v1[0], v1[1]); w.w = cvt_pk_bf16(v1[2], v1[3]);
                    *(u32x4*)op = w; } }
    }
};

struct EpiResF32 {
    static constexpr bool PERM = false, AFTER_DRAIN = false;
    float* C; const float* R; int ldc;
    __device__ __forceinline__ void operator()(const f32x4 (&acc)[2][2][4][2], const Unit& u, int wr, int wc, int fr, int fq) const {
        const int row0 = u.pm * BM + wr * 64 + fr, col0 = u.pn * BM + wc * 32 + 4 * fq;
#pragma unroll
        for (int ai = 0; ai < 2; ++ai)
#pragma unroll
            for (int m = 0; m < 4; ++m) { const size_t off = (size_t)(row0 + ai * HALF + m * 16) * ldc + col0;
#pragma unroll
                for (int bj = 0; bj < 2; ++bj)
#pragma unroll
                    for (int n = 0; n < 2; ++n) { f32x4 v = acc[ai][bj][m][n]; if (R) v += *(const f32x4*)(R + off + bj * HALF + n * 16); *(f32x4*)(C + off + bj * HALF + n * 16) = v; } }
    }
};

struct EpiHiLo {
    static constexpr bool PERM = true, AFTER_DRAIN = false;
    bf16_t* Oh; bf16_t* Ol; int ldc; const float* rowss; float inv_n, eps;
    __device__ __forceinline__ void operator()(const f32x4 (&acc)[2][2][4][2], const Unit& u, int wr, int wc, int fr, int fq) const {
        const int row0 = u.pm * BM + wr * 64 + fr, col0 = u.pn * BM + wc * 32 + 8 * fq;
#pragma unroll
        for (int ai = 0; ai < 2; ++ai)
#pragma unroll
            for (int m = 0; m < 4; ++m) { const int row = row0 + ai * HALF + m * 16; const size_t off = (size_t)row * ldc + col0;
                const float rs = rowss ? 1.0f / sqrtf(__hip_atomic_load(rowss + row, __ATOMIC_RELAXED, __HIP_MEMORY_SCOPE_AGENT) * inv_n + eps) : 1.0f;
#pragma unroll
                for (int bj = 0; bj < 2; ++bj) { const f32x4 v0 = acc[ai][bj][m][0] * rs, v1 = acc[ai][bj][m][1] * rs;
                    u32x4 wh; wh.x = cvt_pk_bf16(v0[0], v0[1]); wh.y = cvt_pk_bf16(v0[2], v0[3]); wh.z = cvt_pk_bf16(v1[0], v1[1]); wh.w = cvt_pk_bf16(v1[2], v1[3]);
                    const f32x4 r0 = v0 - (f32x4){bf_lo(wh.x), bf_hi(wh.x), bf_lo(wh.y), bf_hi(wh.y)}, r1 = v1 - (f32x4){bf_lo(wh.z), bf_hi(wh.z), bf_lo(wh.w), bf_hi(wh.w)};
                    u32x4 wl; wl.x = cvt_pk_bf16(r0[0], r0[1]); wl.y = cvt_pk_bf16(r0[2], r0[3]); wl.z = cvt_pk_bf16(r1[0], r1[1]); wl.w = cvt_pk_bf16(r1[2], r1[3]);
                    *(u32x4*)(Oh + off + bj * HALF) = wh; *(u32x4*)(Ol + off + bj * HALF) = wl; } }
    }
};

struct EpiResNormStat {
    static constexpr bool PERM = true, AFTER_DRAIN = false;
    float* C; const float* R; int ldc; unsigned char* HQ; const float* gain; float* rowss; float qscale; int* rowcs;
    __device__ __forceinline__ void operator()(const f32x4 (&acc)[2][2][4][2], const Unit& u, int wr, int wc, int fr, int fq) const {
        typedef unsigned u32x2_ __attribute__((ext_vector_type(2)));
        const int row0 = u.pm * BM + wr * 64 + fr, col0 = u.pn * BM + wc * 32 + 8 * fq;
        f32x4 gv[2][2];
#pragma unroll
        for (int bj = 0; bj < 2; ++bj)
#pragma unroll
            for (int n = 0; n < 2; ++n) gv[bj][n] = *(const f32x4*)(gain + col0 + bj * HALF + 4 * n);
#pragma unroll
        for (int ai = 0; ai < 2; ++ai)
#pragma unroll
            for (int m = 0; m < 4; ++m) { const int row = row0 + ai * HALF + m * 16; const size_t off = (size_t)row * ldc + col0; float ss = 0.f; int cs = 0;
#pragma unroll
                for (int bj = 0; bj < 2; ++bj) { const f32x4 v0 = acc[ai][bj][m][0] + *(const f32x4*)(R + off + bj * HALF), v1 = acc[ai][bj][m][1] + *(const f32x4*)(R + off + bj * HALF + 4);
                    u32x4 hb; hb.x = cvt_pk_bf16(v0[0], v0[1]); hb.y = cvt_pk_bf16(v0[2], v0[3]); hb.z = cvt_pk_bf16(v1[0], v1[1]); hb.w = cvt_pk_bf16(v1[2], v1[3]);
                    *(u32x4*)((bf16_t*)C + off + bj * HALF) = hb;
                    ss += ((v0[0] * v0[0] + v0[1] * v0[1]) + (v0[2] * v0[2] + v0[3] * v0[3])) + ((v1[0] * v1[0] + v1[1] * v1[1]) + (v1[2] * v1[2] + v1[3] * v1[3]));
                    u32x2_ w; w.x = 0u; w.y = 0u;
#pragma unroll
                    for (int j = 0; j < 4; ++j) { int q0 = (int)rintf(v0[j] * gv[bj][0][j] * qscale), q1 = (int)rintf(v1[j] * gv[bj][1][j] * qscale); q0 = q0 < -127 ? -127 : (q0 > 127 ? 127 : q0); q1 = q1 < -127 ? -127 : (q1 > 127 ? 127 : q1);
                        cs += q0 + q1; w.x |= (unsigned)(q0 & 255) << (8 * j); w.y |= (unsigned)(q1 & 255) << (8 * j); }
                    *(u32x2_*)(HQ + off + bj * HALF) = w; }
                ss += __shfl_xor(ss, 16); ss += __shfl_xor(ss, 32);
                if (fq == 0) __hip_atomic_fetch_add(rowss + row, ss, __ATOMIC_RELAXED, __HIP_MEMORY_SCOPE_AGENT);
                if (rowcs) { cs += __shfl_xor(cs, 16); cs += __shfl_xor(cs, 32); if (fq == 0) __hip_atomic_fetch_add(rowcs + row, cs, __ATOMIC_RELAXED, __HIP_MEMORY_SCOPE_AGENT); } }
    }
};

struct EpiI8Split {
    static constexpr bool PERM = true, AFTER_DRAIN = false;
    bf16_t* O; int ldc; int split_cols; size_t split_stride; const float* rs; float cs; unsigned long long slabmap;
    __device__ __forceinline__ void operator()(const f32x4 (&acc)[2][2][4][2], const Unit& u, int wr, int wc, int fr, int fq) const {
        typedef int i32x4_ __attribute__((ext_vector_type(4)));
        const int row0 = u.pm * BM + wr * 64 + fr; int colt = u.pn * BM; bf16_t* base = O;
        if (split_cols) { const int t = colt / split_cols; base += (size_t)((slabmap >> (4 * t)) & 15ull) * split_stride; colt -= t * split_cols; }
        const int col0 = colt + wc * 32 + 8 * fq;
#pragma unroll
        for (int ai = 0; ai < 2; ++ai)
#pragma unroll
            for (int m = 0; m < 4; ++m) { const int row = row0 + ai * HALF + m * 16; bf16_t* rowp = base + (size_t)row * ldc + col0; const float sc = rs[row] * cs;
#pragma unroll
                for (int bj = 0; bj < 2; ++bj) { const f32x4 a0 = acc[ai][bj][m][0], a1 = acc[ai][bj][m][1]; const i32x4_ i0 = __builtin_bit_cast(i32x4_, a0), i1 = __builtin_bit_cast(i32x4_, a1);
                    u32x4 w; w.x = cvt_pk_bf16((float)i0[0] * sc, (float)i0[1] * sc); w.y = cvt_pk_bf16((float)i0[2] * sc, (float)i0[3] * sc); w.z = cvt_pk_bf16((float)i1[0] * sc, (float)i1[1] * sc); w.w = cvt_pk_bf16((float)i1[2] * sc, (float)i1[3] * sc);
                    *(u32x4*)(rowp + bj * HALF) = w; } }
    }
};

struct EpiHiLoI8 {
    static constexpr bool PERM = true, AFTER_DRAIN = false;
    bf16_t* Oh; bf16_t* Ol; int ldc; const float* rowss; float inv_n, eps, cs;
    __device__ __forceinline__ void operator()(const f32x4 (&acc)[2][2][4][2], const Unit& u, int wr, int wc, int fr, int fq) const {
        typedef int i32x4_ __attribute__((ext_vector_type(4)));
        const int row0 = u.pm * BM + wr * 64 + fr, col0 = u.pn * BM + wc * 32 + 8 * fq;
#pragma unroll
        for (int ai = 0; ai < 2; ++ai)
#pragma unroll
            for (int m = 0; m < 4; ++m) { const int row = row0 + ai * HALF + m * 16; const size_t off = (size_t)row * ldc + col0;
                const float rs = cs / sqrtf(__hip_atomic_load(rowss + row, __ATOMIC_RELAXED, __HIP_MEMORY_SCOPE_AGENT) * inv_n + eps);
#pragma unroll
                for (int bj = 0; bj < 2; ++bj) { const f32x4 a0 = acc[ai][bj][m][0], a1 = acc[ai][bj][m][1]; const i32x4_ i0 = __builtin_bit_cast(i32x4_, a0), i1 = __builtin_bit_cast(i32x4_, a1);
                    const f32x4 v0 = (f32x4){(float)i0[0], (float)i0[1], (float)i0[2], (float)i0[3]} * rs, v1 = (f32x4){(float)i1[0], (float)i1[1], (float)i1[2], (float)i1[3]} * rs;
                    u32x4 wh; wh.x = cvt_pk_bf16(v0[0], v0[1]); wh.y = cvt_pk_bf16(v0[2], v0[3]); wh.z = cvt_pk_bf16(v1[0], v1[1]); wh.w = cvt_pk_bf16(v1[2], v1[3]);
                    const f32x4 r0 = v0 - (f32x4){bf_lo(wh.x), bf_hi(wh.x), bf_lo(wh.y), bf_hi(wh.y)}, r1 = v1 - (f32x4){bf_lo(wh.z), bf_hi(wh.z), bf_lo(wh.w), bf_hi(wh.w)};
                    u32x4 wl; wl.x = cvt_pk_bf16(r0[0], r0[1]); wl.y = cvt_pk_bf16(r0[2], r0[3]); wl.z = cvt_pk_bf16(r1[0], r1[1]); wl.w = cvt_pk_bf16(r1[2], r1[3]);
                    *(u32x4*)(Oh + off + bj * HALF) = wh; if (Ol) *(u32x4*)(Ol + off + bj * HALF) = wl; } }
    }
};
template <class Epi, class Sched, bool ALIGN_EPI = false, bool SP2 = false, bool I8 = false>
__device__ __forceinline__ void gemm_phase(PG8_LAS unsigned char* lds, const Gemm g, const Sched& S, const Epi& E) {
    const int tid = threadIdx.x, wid = __builtin_amdgcn_readfirstlane(tid >> 6), lane = tid & 63, wr = wid >> 2, wc = wid & 3, fr = lane & 15, fq = lane >> 4;
    const int K = g.K, nt = K / BK;
    unsigned voffA[2], voffB[2];
#pragma unroll
    for (int i = 0; i < 2; ++i) { int R, C; stage_rc(tid * 16 + i * 8192, R, C); const int Rb = Epi::PERM ? ((R & ~31) + perm32(R & 31)) : R;
        voffA[i] = (unsigned)(R * K + C) * 2u; voffB[i] = (unsigned)(Rb * K + C) * 2u; }
    const size_t kstep = (size_t)(BK * 2);
    const size_t hstep = (size_t)HALF * K * 2;
    const size_t tstep = 2 * hstep;
    const unsigned ldsw = (unsigned)wid * 1024u;
    const int aoff = lds_byte(wr * 64 + fr, fq * 8), boff = lds_byte(wc * 32 + fr, fq * 8);
#define PG8_SA(b, h) (((b) * 2 + (h)) * HTB)
#define PG8_SB(b, h) ((4 + (b) * 2 + (h)) * HTB)
#define PG8_STAGE(bufoff, gbase, voff) do { _Pragma("unroll") for (int _i = 0; _i < 2; ++_i) \
        __builtin_amdgcn_global_load_lds((const unsigned*)((const char*)(gbase) + (voff)[_i]), (PG8_LAS unsigned*)(lds + (bufoff) + ldsw + _i * 8192), 16, 0, 0); } while (0)
#define PG8_LDA(dst, b, h) do { _Pragma("unroll") for (int m = 0; m < 4; ++m) _Pragma("unroll") for (int k = 0; k < 2; ++k) dst[m][k] = *(const PG8_LAS bf16x8*)(lds + PG8_SA(b, h) + aoff + m * 2048 + k * 1024); } while (0)
#define PG8_LDB(dst, b, h) do { _Pragma("unroll") for (int n = 0; n < 2; ++n) _Pragma("unroll") for (int k = 0; k < 2; ++k) dst[n][k] = *(const PG8_LAS bf16x8*)(lds + PG8_SB(b, h) + boff + n * 2048 + k * 1024); } while (0)
#define PG8_MMA(ai, bj, At, Bt) do { __builtin_amdgcn_s_setprio(1); _Pragma("unroll") for (int m = 0; m < 4; ++m) _Pragma("unroll") for (int n = 0; n < 2; ++n) _Pragma("unroll") for (int k = 0; k < 2; ++k) { \
        if constexpr (I8) { typedef int i32x4_ __attribute__((ext_vector_type(4))); const bf16x8 bq_ = Bt[n][k], aq_ = At[m][k]; const f32x4 cq_ = acc[ai][bj][m][n]; \
            acc[ai][bj][m][n] = __builtin_bit_cast(f32x4, __builtin_amdgcn_mfma_i32_16x16x64_i8(__builtin_bit_cast(i32x4_, bq_), __builtin_bit_cast(i32x4_, aq_), __builtin_bit_cast(i32x4_, cq_), 0, 0, 0)); } \
        else acc[ai][bj][m][n] = __builtin_amdgcn_mfma_f32_16x16x32_bf16(Bt[n][k], At[m][k], acc[ai][bj][m][n], 0, 0, 0); } __builtin_amdgcn_s_setprio(0); } while (0)
#define PG8_WAIT_V(n) asm volatile("s_waitcnt vmcnt(" #n ")" ::: "memory")
#define PG8_WAIT_L(n) asm volatile("s_waitcnt lgkmcnt(" #n ")" ::: "memory")
#define PG8_BAR __builtin_amdgcn_s_barrier()
#define PG8_SCHED __builtin_amdgcn_sched_barrier(0)
    Unit cur, nxt; int ui = 0;
    if (!S.next(0, cur)) return;
    f32x4 acc[2][2][4][2];
#pragma unroll
    for (int a = 0; a < 2; ++a)
#pragma unroll
        for (int b = 0; b < 2; ++b)
#pragma unroll
            for (int m = 0; m < 4; ++m)
#pragma unroll
                for (int n = 0; n < 2; ++n) acc[a][b][m][n] = (f32x4){0.f, 0.f, 0.f, 0.f};
    bf16x8 At[4][2], B0[2][2], B1[2][2];
    const char* cA = (const char*)g.A + (size_t)cur.pm * tstep; const char* cB = (const char*)g.Bt + (size_t)cur.pn * tstep;
    S.a_ready(cur);
    if constexpr (SP2) {
        PG8_STAGE(PG8_SB(0, 0), cB, voffB); PG8_STAGE(PG8_SB(0, 1), cB + hstep, voffB); PG8_STAGE(PG8_SA(0, 0), cA, voffA); PG8_STAGE(PG8_SA(0, 1), cA + hstep, voffA);
        if (wr == 1) PG8_BAR;
        PG8_WAIT_V(2); PG8_BAR;
        PG8_STAGE(PG8_SB(1, 0), cB + kstep, voffB); PG8_STAGE(PG8_SA(1, 0), cA + kstep, voffA); PG8_STAGE(PG8_SB(1, 1), cB + hstep + kstep, voffB);
        PG8_WAIT_V(6); PG8_BAR;
    } else {
        PG8_STAGE(PG8_SB(0, 0), cB, voffB); PG8_STAGE(PG8_SA(0, 0), cA, voffA); PG8_STAGE(PG8_SB(0, 1), cB + hstep, voffB); PG8_STAGE(PG8_SA(0, 1), cA + hstep, voffA);
        if (wr == 1) PG8_BAR;
        PG8_WAIT_V(4); PG8_BAR;
        PG8_STAGE(PG8_SB(1, 0), cB + kstep, voffB); PG8_STAGE(PG8_SA(1, 0), cA + kstep, voffA); PG8_STAGE(PG8_SB(1, 1), cB + hstep + kstep, voffB);
        PG8_WAIT_V(6); PG8_BAR;
    }
    for (;;) {
        const bool has_next = S.next(ui + 1, nxt);
        const char* nA = has_next ? (const char*)g.A + (size_t)nxt.pm * tstep : cA; const char* nB = has_next ? (const char*)g.Bt + (size_t)nxt.pn * tstep : cB;
        for (int t = 0; t < nt; t += 2) {
            const bool last = (t == nt - 2);
            const char* a1 = cA + (size_t)(t + 1) * kstep;
            const char* a2 = last ? nA : cA + (size_t)(t + 2) * kstep; const char* b2 = last ? nB : cB + (size_t)(t + 2) * kstep;
            const char* a3 = a2 + kstep; const char* b3 = b2 + kstep;
            if (last && has_next) S.a_ready(nxt);
            if constexpr (SP2) {
            PG8_LDB(B0, 0, 0); PG8_LDB(B1, 0, 1); PG8_SCHED; PG8_LDA(At, 0, 0); PG8_STAGE(PG8_SA(1, 1), a1 + hstep, voffA);
            PG8_WAIT_V(8); PG8_WAIT_L(0); PG8_BAR; PG8_MMA(0, 0, At, B0); PG8_MMA(0, 1, At, B1); PG8_BAR; PG8_SCHED;
            PG8_LDA(At, 0, 1); PG8_STAGE(PG8_SB(0, 0), b2, voffB); PG8_STAGE(PG8_SB(0, 1), b2 + hstep, voffB); PG8_STAGE(PG8_SA(0, 0), a2, voffA);
            PG8_WAIT_V(8); PG8_WAIT_L(0); PG8_BAR; PG8_MMA(1, 0, At, B0); PG8_MMA(1, 1, At, B1); PG8_BAR; PG8_SCHED;
            PG8_LDB(B0, 1, 0); PG8_LDB(B1, 1, 1); PG8_SCHED; PG8_LDA(At, 1, 0); PG8_STAGE(PG8_SA(0, 1), a2 + hstep, voffA);
            PG8_WAIT_V(8); PG8_WAIT_L(0); PG8_BAR; PG8_MMA(0, 0, At, B0); PG8_MMA(0, 1, At, B1); PG8_BAR; PG8_SCHED;
            PG8_LDA(At, 1, 1); PG8_STAGE(PG8_SB(1, 0), b3, voffB); PG8_STAGE(PG8_SB(1, 1), b3 + hstep, voffB); PG8_STAGE(PG8_SA(1, 0), a3, voffA);
            PG8_WAIT_V(8); PG8_WAIT_L(0); PG8_BAR; PG8_MMA(1, 0, At, B0); PG8_MMA(1, 1, At, B1); PG8_BAR; PG8_SCHED;
            } else {
            PG8_LDB(B0, 0, 0); PG8_SCHED; PG8_LDA(At, 0, 0); PG8_STAGE(PG8_SA(1, 1), a1 + hstep, voffA);
            PG8_WAIT_L(8); PG8_BAR; PG8_WAIT_L(0); PG8_MMA(0, 0, At, B0); PG8_BAR; PG8_SCHED;
            PG8_LDB(B1, 0, 1); PG8_STAGE(PG8_SB(0, 0), b2, voffB);
            PG8_BAR; PG8_WAIT_L(0); PG8_MMA(0, 1, At, B1); PG8_BAR;
            PG8_LDA(At, 0, 1); PG8_STAGE(PG8_SA(0, 0), a2, voffA);
            PG8_BAR; PG8_WAIT_L(0); PG8_MMA(1, 0, At, B0); PG8_BAR; PG8_SCHED;
            PG8_STAGE(PG8_SB(0, 1), b2 + hstep, voffB);
            PG8_WAIT_V(6); PG8_BAR; PG8_MMA(1, 1, At, B1); PG8_BAR;
            PG8_LDB(B0, 1, 0); PG8_SCHED; PG8_LDA(At, 1, 0); PG8_STAGE(PG8_SA(0, 1), a2 + hstep, voffA);
            PG8_WAIT_L(8); PG8_BAR; PG8_WAIT_L(0); PG8_MMA(0, 0, At, B0); PG8_BAR; PG8_SCHED;
            PG8_LDB(B1, 1, 1); PG8_STAGE(PG8_SB(1, 0), b3, voffB);
            PG8_BAR; PG8_WAIT_L(0); PG8_MMA(0, 1, At, B1); PG8_BAR;
            PG8_LDA(At, 1, 1); PG8_STAGE(PG8_SA(1, 0), a3, voffA);
            PG8_BAR; PG8_WAIT_L(0); PG8_MMA(1, 0, At, B0); PG8_BAR; PG8_SCHED;
            PG8_STAGE(PG8_SB(1, 1), b3 + hstep, voffB);
            PG8_WAIT_V(6); PG8_BAR; PG8_MMA(1, 1, At, B1); PG8_BAR;
            }
        }
        if constexpr (ALIGN_EPI) { if (wr == 0) PG8_BAR; }
        if constexpr (!Epi::AFTER_DRAIN) { E(acc, cur, wr, wc, fr, fq); S.done(cur); }
        if (!has_next) break;
#pragma unroll
        for (int a = 0; a < 2; ++a)
#pragma unroll
            for (int b = 0; b < 2; ++b)
#pragma unroll
                for (int m = 0; m < 4; ++m)
#pragma unroll
                    for (int n = 0; n < 2; ++n) acc[a][b][m][n] = (f32x4){0.f, 0.f, 0.f, 0.f};
        cur = nxt; cA = nA; cB = nB; ++ui;
        if constexpr (ALIGN_EPI) { if (wr == 1) PG8_BAR; }
    }
    PG8_WAIT_V(0);
    if constexpr (!ALIGN_EPI) { if (wr == 0) PG8_BAR; }
    PG8_BAR;
    if constexpr (Epi::AFTER_DRAIN) { E.fused(acc, cur, wr, wc, fr, fq, lds, wid, lane); S.done(cur); }
#undef PG8_SA
#undef PG8_SB
#undef PG8_STAGE
#undef PG8_LDA
#undef PG8_LDB
#undef PG8_MMA
#undef PG8_WAIT_V
#undef PG8_WAIT_L
#undef PG8_BAR
#undef PG8_SCHED
}
}

namespace moba {
typedef unsigned short bf16;
typedef short bf16x8 __attribute__((ext_vector_type(8)));
typedef short s16x4 __attribute__((ext_vector_type(4)));
typedef float f32x16 __attribute__((ext_vector_type(16)));
typedef float f32x4 __attribute__((ext_vector_type(4)));
typedef unsigned u32x4 __attribute__((ext_vector_type(4)));
constexpr int D = 128, PITCH = 2048, SEQ = 2048, NHEAD = 16;
constexpr float SCALE = 0.08838834764831845f;
constexpr float THR = 8.f;
constexpr float ATT_SCALE = 127.0f / 3.0f;
constexpr int NW = 8, QBLK = 32, KVBLK = 64, QB = NW * QBLK;
constexpr int SHM_V = KVBLK * D * 2, SHM_K = KVBLK * D * 2;
constexpr int LDS_WS = 2 * SHM_V + 2 * SHM_K, LDS_KM = LDS_WS + NW * 64 * 4, LDS_BQ = LDS_KM + 8 * 128 * 4, LDS_Q = LDS_BQ + 144 * 4, LDS_BYTES = LDS_Q + NW * 8192;

#define KSWZ(row, colB) ((row) * 256 + ((colB) ^ (((row) & 7) << 4)))
#define SBAR() __builtin_amdgcn_sched_barrier(0)
__device__ __forceinline__ int v_st(int k, int c) { const int kk = (k & ~0xC) | ((k & 4) << 1) | ((k & 8) >> 1); return ((kk >> 3) * 4 + (c >> 5)) * 512 + ((kk & 7) * 32 + (c & 31)) * 2; }
__device__ __forceinline__ int v_rd_base(int lane) { return ((lane & 3) << 3) | (((lane >> 2) & 3) << 6) | (((lane >> 4) & 1) << 5) | (((lane >> 5) & 1) << 8); }
constexpr int v_rd_off(int d0, int ks, int half) { return d0 * 512 + ks * 4096 + half * 2048; }
__device__ __forceinline__ int crow(int r, int hi) { return (r & 3) + 8 * (r >> 2) + 4 * hi; }
__device__ __forceinline__ unsigned cvtpk(float lo, float hi) { unsigned r; asm volatile("v_cvt_pk_bf16_f32 %0, %1, %2" : "=v"(r) : "v"(lo), "v"(hi)); return r; }
__device__ __forceinline__ bf16x8 load8(const bf16* p) { return *reinterpret_cast<const bf16x8*>(p); }

__device__ __forceinline__ void moba_mask(f32x16& p0, f32x16& p1, int kb, int qpos, int qlo, int hi, int P0, unsigned selbits, const float* biasq) {
    const float NEG = -__builtin_inff();
    const int dq = qpos - 4 * hi - kb;
    const bool own = kb >= P0;
    const bool near = kb + KVBLK - 1 > qlo - 128;
    if (!own) {
        const bool sel = ((selbits >> (kb >> 8)) & 1u) != 0u;
        if (near) {
#pragma unroll
            for (int r = 0; r < 16; ++r) {
                const int e0 = dq - ((r & 3) + 8 * (r >> 2)), e1 = e0 - 32;
                const int d0 = e0 > 128 ? 128 : e0, d1 = e1 > 128 ? 128 : (e1 < 0 ? 0 : e1);
                const float b0 = biasq[d0 < 0 ? 0 : d0], b1 = biasq[d1];
                p0[r] = sel ? p0[r] + b0 : NEG; p1[r] = sel ? p1[r] + b1 : NEG;
            }
        } else {
#pragma unroll
            for (int r = 0; r < 16; ++r) { p0[r] = sel ? p0[r] : NEG; p1[r] = sel ? p1[r] : NEG; }
        }
    } else if (near) {
#pragma unroll
        for (int r = 0; r < 16; ++r) {
            const int e0 = dq - ((r & 3) + 8 * (r >> 2)), e1 = e0 - 32;
            int d0 = e0 > 128 ? 128 : e0, d1 = e1 > 128 ? 128 : e1; d0 = d0 < 0 ? 0 : d0; d1 = d1 < 0 ? 0 : d1;
            const float b0 = biasq[d0], b1 = biasq[d1];
            p0[r] = e0 >= 0 ? p0[r] + b0 : NEG; p1[r] = e1 >= 0 ? p1[r] + b1 : NEG;
        }
    }
}
__device__ __forceinline__ void partialSM(f32x16& p0, f32x16& p1, float& m_reg, float& mn, float& alpha) {
    float pmax = p0[0]; for (int r = 1; r < 16; ++r) pmax = fmaxf(pmax, p0[r]); for (int r = 0; r < 16; ++r) pmax = fmaxf(pmax, p1[r]);
    { auto rr = __builtin_amdgcn_permlane32_swap(__float_as_uint(pmax), __float_as_uint(pmax), false, false);
      pmax = fmaxf(__uint_as_float(rr[0]), __uint_as_float(rr[1])); }
    constexpr float C2 = 1.4426950408889634f * SCALE;
    if (__builtin_expect(__all((pmax - m_reg) * SCALE <= THR), 1)) { mn = m_reg; alpha = 1.f; }
    else { mn = fmaxf(m_reg, pmax); alpha = __builtin_amdgcn_exp2f((m_reg - mn) * C2); m_reg = mn; }
    const float mnL = -mn * C2;
    for (int r = 0; r < 16; ++r) p0[r] = fmaf(p0[r], C2, mnL); for (int r = 0; r < 16; ++r) p1[r] = fmaf(p1[r], C2, mnL);
    for (int r = 0; r < 16; ++r) p0[r] = __builtin_amdgcn_exp2f(p0[r]);
}
__device__ __forceinline__ void finishSM(f32x16& p0, f32x16& p1, float alpha, float& l_reg, bf16x8& pa0, bf16x8& pa1, bf16x8& pa2, bf16x8& pa3) {
    for (int r = 0; r < 16; ++r) p1[r] = __builtin_amdgcn_exp2f(p1[r]);
    float ps = 0; for (int r = 0; r < 16; ++r) ps += p0[r]; for (int r = 0; r < 16; ++r) ps += p1[r];
    { auto rr = __builtin_amdgcn_permlane32_swap(__float_as_uint(ps), __float_as_uint(ps), false, false);
      ps = __uint_as_float(rr[0]) + __uint_as_float(rr[1]); }
    l_reg = l_reg * alpha + ps;
#define PK4(P, B_, OUT) do { unsigned a0 = cvtpk(P[B_+0], P[B_+1]), a1 = cvtpk(P[B_+2], P[B_+3]);                          \
        unsigned b0 = cvtpk(P[B_+4], P[B_+5]), b1 = cvtpk(P[B_+6], P[B_+7]);                                             \
        auto r0 = __builtin_amdgcn_permlane32_swap(a0, b0, false, false); auto r1 = __builtin_amdgcn_permlane32_swap(a1, b1, false, false); \
        u32x4 w = {r0[0], r1[0], r0[1], r1[1]}; OUT = *reinterpret_cast<bf16x8*>(&w); } while (0)
    PK4(p0, 0, pa0); PK4(p0, 8, pa1); PK4(p1, 0, pa2); PK4(p1, 8, pa3);
#undef PK4
}
template <int KB>
__device__ __forceinline__ void qkt(f32x16& p0, f32x16& p1, const char* K_lds, int r32, int hi, const char* qf) {
    p0 = f32x16{}; p1 = f32x16{};
    const char* kb[4];
#pragma unroll
    for (int dd = 0; dd < 4; ++dd) kb[dd] = K_lds + KB * SHM_K + KSWZ(r32, (dd * 16 + hi * 8) * 2);
#pragma unroll
    for (int d0 = 0; d0 < 8; ++d0) { const char* a = kb[d0 & 3] + (d0 >> 2) * 128;
        bf16x8 b0 = *reinterpret_cast<const bf16x8*>(a);
        bf16x8 b1 = *reinterpret_cast<const bf16x8*>(a + 32 * 256);
        const bf16x8 qd = *reinterpret_cast<const bf16x8*>(qf + d0 * 1024);
        p0 = __builtin_amdgcn_mfma_f32_32x32x16_bf16(b0, qd, p0, 0, 0, 0);
        p1 = __builtin_amdgcn_mfma_f32_32x32x16_bf16(b1, qd, p1, 0, 0, 0); }
}
template <int VB>
__device__ __forceinline__ void pv_tile(f32x16* o, int vb0, bf16x8 pa0, bf16x8 pa1, bf16x8 pa2, bf16x8 pa3) {
#define TRRD(dst, off) asm volatile("ds_read_b64_tr_b16 %0, %1 offset:%2" : "=&v"(dst) : "v"(vb0), "i"(off) : "memory")
#define PV_D0(d0) do { s16x4 l0, l1, l2, l3, h0, h1, h2, h3; constexpr int b_ = VB * SHM_V + v_rd_off(d0, 0, 0); \
        TRRD(l0, b_); TRRD(h0, b_ + 2048); TRRD(l1, b_ + 4096); TRRD(h1, b_ + 6144); TRRD(l2, b_ + 8192); TRRD(h2, b_ + 10240); TRRD(l3, b_ + 12288); TRRD(h3, b_ + 14336); \
        asm volatile("s_waitcnt lgkmcnt(0)" ::: "memory"); SBAR();   \
        o[d0] = __builtin_amdgcn_mfma_f32_32x32x16_bf16(pa0, (bf16x8){l0[0], l0[1], l0[2], l0[3], h0[0], h0[1], h0[2], h0[3]}, o[d0], 0, 0, 0);   \
        o[d0] = __builtin_amdgcn_mfma_f32_32x32x16_bf16(pa1, (bf16x8){l1[0], l1[1], l1[2], l1[3], h1[0], h1[1], h1[2], h1[3]}, o[d0], 0, 0, 0);   \
        o[d0] = __builtin_amdgcn_mfma_f32_32x32x16_bf16(pa2, (bf16x8){l2[0], l2[1], l2[2], l2[3], h2[0], h2[1], h2[2], h2[3]}, o[d0], 0, 0, 0);   \
        o[d0] = __builtin_amdgcn_mfma_f32_32x32x16_bf16(pa3, (bf16x8){l3[0], l3[1], l3[2], l3[3], h3[0], h3[1], h3[2], h3[3]}, o[d0], 0, 0, 0); } while (0)
    PV_D0(0); PV_D0(1); PV_D0(2); PV_D0(3);
#undef PV_D0
#undef TRRD
}

struct BlockRef { const bf16* Q; const bf16* K; const bf16* V; unsigned char* O;     const float* kmean; const float* relh; int P0; };
struct Seam { bf16x8 qr[8]; bf16x8 st_v0, st_v1, st_k0, st_k1; };
#define VMW() asm volatile("s_waitcnt vmcnt(0)" ::: "memory")
#define VMWN(n) asm volatile("s_waitcnt vmcnt(%0)" :: "i"(n) : "memory")
#define SLOAD_H(Kp, Vp, k0) do { const bf16* kt_ = (Kp) + (size_t)(k0) * PITCH; const bf16* vt_ = (Vp) + (size_t)(k0) * PITCH;                    \
                         S.st_v0 = load8(vt_ + ko0); S.st_v1 = load8(vt_ + ko1); S.st_k0 = load8(kt_ + ko0); S.st_k1 = load8(kt_ + ko1); } while (0)
#define SWRITE_HK(bf) do { *(bf16x8*)(K_lds + (bf) * SHM_K + kws) = S.st_k0; *(bf16x8*)(K_lds + (bf) * SHM_K + kws + 32 * 256) = S.st_k1; } while (0)
#define SWRITE_HV(bf) do { *(bf16x8*)(V_lds + (bf) * SHM_V + vst0) = S.st_v0; *(bf16x8*)(V_lds + (bf) * SHM_V + vst1) = S.st_v1; } while (0)
#define SWRITE_H(bf) do { SWRITE_HV(bf); SWRITE_HK(bf); } while (0)
__device__ __forceinline__ void moba_prime(const BlockRef& cur, char* lds, Seam& S) {
    const int tid = threadIdx.x, wid = __builtin_amdgcn_readfirstlane(tid >> 6), lane = tid & 63, r32 = lane & 31, hi = lane >> 5;
    const int sr = tid >> 4, sc = (tid & 15) * 8, kws = KSWZ(sr, sc * 2); char* K_lds = lds + 2 * SHM_V;
    const unsigned ko0 = (unsigned)(sr * PITCH + sc), ko1 = ko0 + 32u * PITCH, qo = (unsigned)((wid * QBLK + r32) * PITCH + hi * 8);
    for (int d0 = 0; d0 < 8; ++d0) S.qr[d0] = load8(cur.Q + qo + d0 * 16);
    SLOAD_H(cur.K, cur.V, 0); VMW(); SWRITE_HK(0);
    __syncthreads();
}
__device__ __forceinline__ void moba_block(const BlockRef& cur, const BlockRef& nxt, char* lds, Seam& S) {
    const int tid = threadIdx.x, wid = __builtin_amdgcn_readfirstlane(tid >> 6), lane = tid & 63, r32 = lane & 31, hi = lane >> 5;
    const int NT = (cur.P0 + QB) / KVBLK;
    const int qlo = cur.P0 + wid * QBLK, qpos = qlo + r32;
    char* V_lds = lds; char* K_lds = lds + 2 * SHM_V;
    float* ws = (float*)(lds + LDS_WS) + wid * 64; float* li_l = ws, * al_l = ws + 32;
    float* km_l = (float*)(lds + LDS_KM); float* bq_l = (float*)(lds + LDS_BQ);
    float m_reg = -1e30f, l_reg = 0; f32x16 o[4] = {};
    const int sr = tid >> 4, sc = (tid & 15) * 8, vst0 = v_st(sr, sc), vst1 = v_st(32 + sr, sc), kws = KSWZ(sr, sc * 2);
    const unsigned ko0 = (unsigned)(sr * PITCH + sc), ko1 = ko0 + 32u * PITCH, qo = (unsigned)((wid * QBLK + r32) * PITCH + hi * 8);
    const int vb0 = (int)(uintptr_t)V_lds + v_rd_base(lane);
    const bf16* Kh = cur.K; const bf16* Vh = cur.V;
    char* qf = lds + LDS_Q + wid * 8192 + lane * 16;
#pragma unroll
    for (int d0 = 0; d0 < 8; ++d0) *reinterpret_cast<bf16x8*>(qf + d0 * 1024) = S.qr[d0];
    { const float2 km = *(const float2*)(cur.kmean + tid * 2); *(float2*)(km_l + tid * 2) = km;
      if (tid < 144) { float bv = 0.f;
          if (tid < 128) { int bk = tid; if (tid >= 16) { bk = 16 + (int)(__log2f((float)tid * 0.0625f) * (16.0f / 3.0f)); bk = bk > 31 ? 31 : bk; }
              bv = (cur.relh[bk * NHEAD] - cur.relh[31 * NHEAD]) * (1.0f / SCALE); }
          bq_l[tid] = bv; } }
    __syncthreads();
    unsigned selbits = 0u;
    { const int qb = cur.P0 >> 8;
      float g[7];
#pragma unroll
      for (int n = 0; n < 7; ++n) { g[n] = 0.f;
          if (n < qb) { float s = 0.f;
#pragma unroll
              for (int d0 = 0; d0 < 8; ++d0) { const f32x4 k0 = *(const f32x4*)(km_l + n * 128 + d0 * 16 + hi * 8), k1 = *(const f32x4*)(km_l + n * 128 + d0 * 16 + hi * 8 + 4);
                  const bf16x8 q = S.qr[d0];
                  s = fmaf(__uint_as_float((unsigned)(unsigned short)q[0] << 16), k0[0], s); s = fmaf(__uint_as_float((unsigned)(unsigned short)q[1] << 16), k0[1], s);
                  s = fmaf(__uint_as_float((unsigned)(unsigned short)q[2] << 16), k0[2], s); s = fmaf(__uint_as_float((unsigned)(unsigned short)q[3] << 16), k0[3], s);
                  s = fmaf(__uint_as_float((unsigned)(unsigned short)q[4] << 16), k1[0], s); s = fmaf(__uint_as_float((unsigned)(unsigned short)q[5] << 16), k1[1], s);
                  s = fmaf(__uint_as_float((unsigned)(unsigned short)q[6] << 16), k1[2], s); s = fmaf(__uint_as_float((unsigned)(unsigned short)q[7] << 16), k1[3], s); }
              auto rr = __builtin_amdgcn_permlane32_swap(__float_as_uint(s), __float_as_uint(s), false, false);
              g[n] = __uint_as_float(rr[0]) + __uint_as_float(rr[1]); } }
#pragma unroll
      for (int n = 0; n < 7; ++n) { if (n < qb) { int rank = 0;
#pragma unroll
              for (int m2 = 0; m2 < 7; ++m2) { if (m2 != n && m2 < qb) rank += (g[m2] > g[n] || (g[m2] == g[n] && m2 < n)) ? 1 : 0; }
              if (rank < 3) selbits |= 1u << n; } } }
#define RESC(a) do { if (__any((a) < 1.f)) { if (hi == 0) al_l[r32] = (a); asm volatile("s_waitcnt lgkmcnt(0)" ::: "memory");              \
                     for (int d_ = 0; d_ < 4; ++d_) for (int r = 0; r < 16; ++r) o[d_][r] *= al_l[crow(r, hi)]; } } while (0)
#define KBASE(t) ((t) * KVBLK)
#ifdef NOMASK
#define MASKT(P0_, P1_, t) do {} while (0)
#else
#define MASKT(P0_, P1_, t) moba_mask(P0_, P1_, KBASE(t), qpos, qlo, hi, cur.P0, selbits, bq_l)
#endif
    constexpr int NQL = 8;
#define SEAM_K0() do { VMWN(NQL); SWRITE_HK(0); SBAR(); } while (0)
    f32x16 pA0, pA1, pB0, pB1; float mnA, mnB, alA, alB; bf16x8 pa0, pa1, pa2, pa3;
    SWRITE_HV(0); SBAR();
    if (NT > 1) SLOAD_H(Kh, Vh, KBASE(1));
    SBAR(); qkt<0>(pA0, pA1, K_lds, r32, hi, qf);
    MASKT(pA0, pA1, 0); partialSM(pA0, pA1, m_reg, mnA, alA);
    if (NT > 1) { VMW(); SWRITE_H(1); }
    __syncthreads();
#define HALF_STEP(PX0, PX1, mnX, alX, PY0, PY1, alY, t, KB, VB, SB) do {                                                      \
        SBAR(); qkt<KB>(PX0, PX1, K_lds, r32, hi, qf);                                                                      \
        finishSM(PY0, PY1, alY, l_reg, pa0, pa1, pa2, pa3); SBAR();                                                           \
        if ((t) + 1 < NT) { SLOAD_H(Kh, Vh, KBASE((t) + 1)); SBAR(); }                                                        \
        pv_tile<VB>(o, vb0, pa0, pa1, pa2, pa3); MASKT(PX0, PX1, (t)); partialSM(PX0, PX1, m_reg, mnX, alX);                  \
        __syncthreads();                                                                                                      \
        if ((t) + 1 < NT) { VMW(); SWRITE_H(SB); }                                                                            \
        RESC(alX); __syncthreads(); } while (0)
    for (int t = 1; t + 1 < NT; t += 2) {
        HALF_STEP(pB0, pB1, mnB, alB, pA0, pA1, alA, t, 1, 0, 0);
        HALF_STEP(pA0, pA1, mnA, alA, pB0, pB1, alB, t + 1, 0, 1, 1);
    }
    const bool even = (NT & 1) == 0;
    if (even) { SBAR(); qkt<1>(pB0, pB1, K_lds, r32, hi, qf); SBAR(); }
    SLOAD_H(nxt.K, nxt.V, 0); SBAR();
#pragma unroll
    for (int d0 = 0; d0 < 8; ++d0) S.qr[d0] = load8(nxt.Q + qo + d0 * 16);
    SBAR();
    finishSM(pA0, pA1, alA, l_reg, pa0, pa1, pa2, pa3); SBAR();
    pv_tile<0>(o, vb0, pa0, pa1, pa2, pa3);
    if (even) { MASKT(pB0, pB1, NT - 1); partialSM(pB0, pB1, m_reg, mnB, alB); __syncthreads(); RESC(alB);
        finishSM(pB0, pB1, alB, l_reg, pa0, pa1, pa2, pa3); SBAR(); pv_tile<1>(o, vb0, pa0, pa1, pa2, pa3); }
    SBAR(); SEAM_K0();
    if (hi == 0) li_l[r32] = l_reg; asm volatile("s_waitcnt lgkmcnt(0)" ::: "memory");
    float rli[16];
#pragma unroll
    for (int r = 0; r < 16; ++r) rli[r] = __builtin_amdgcn_rcpf(li_l[crow(r, hi)]) * ATT_SCALE;
    unsigned char* Ow = cur.O + (size_t)(wid * QBLK) * PITCH;
#pragma unroll
    for (int r = 0; r < 16; ++r) { const int orow = crow(r, hi);
#pragma unroll
        for (int d0 = 0; d0 < 4; ++d0) {
            const unsigned b = (unsigned)(int)rintf(fminf(fmaxf(o[d0][r] * rli[r], -127.f), 127.f)) & 255u;
            const unsigned w = b | ((unsigned)__builtin_amdgcn_update_dpp(0, (int)b, 0xB1, 0xF, 0xF, false) << 8);
            const unsigned w2 = w | ((unsigned)__builtin_amdgcn_update_dpp(0, (int)w, 0x4E, 0xF, 0xF, false) << 16);
            if ((r32 & 3) == 0) *(unsigned*)(Ow + (size_t)orow * PITCH + d0 * 32 + r32) = w2; } }
    __syncthreads();
#undef RESC
#undef KBASE
#undef MASKT
#undef SEAM_K0
#undef HALF_STEP
}
#undef VMW
#undef VMWN
#undef SLOAD_H
#undef SWRITE_HK
#undef SWRITE_HV
#undef SWRITE_H
#undef KSWZ
#undef SBAR
}
#define XB_TMO      128
#define XB_XCNT(j)  (256  + 64 * (j))
#define XB_XSUB(j)  (1280 + 64 * (j))
#define XB_XGEN(j)  (2304 + 64 * (j))
#define XB_TOP      3328
#define XB_TOPGEN   3392
#define XCD_BAR_WORDS 3456
#define XB_SPIN_CAP (1u << 18)
#define LAS __attribute__((address_space(3)))

__device__ __forceinline__ unsigned xb_ld(unsigned* p)              { return __hip_atomic_load(p, __ATOMIC_RELAXED, __HIP_MEMORY_SCOPE_AGENT); }
__device__ __forceinline__ unsigned xb_add(unsigned* p, unsigned v) { return __hip_atomic_fetch_add(p, v, __ATOMIC_RELAXED, __HIP_MEMORY_SCOPE_AGENT); }
__device__ __forceinline__ unsigned xb_xcc_id() { return (unsigned)__builtin_amdgcn_s_getreg((3 << 11) | 20) & 0xFu; }
#define XB_SPIN(cond, bar) do { unsigned _sp = 0; while (cond) { __builtin_amdgcn_s_sleep(1); \
    if ((++_sp & 255u) == 0u) { if (xb_ld(&(bar)[XB_TMO])) break; if (_sp > XB_SPIN_CAP) { atomicAdd(&(bar)[XB_TMO], 1u); break; } } } } while (0)

struct XcdBarrier {
    unsigned* bar; unsigned x;
    volatile LAS unsigned* st;
};

__device__ __forceinline__ XcdBarrier xcd_barrier_post(unsigned* bar, volatile LAS unsigned* st) {
    XcdBarrier b; b.bar = bar; b.x = xb_xcc_id(); b.st = st;
    if (threadIdx.x == 0) (void)xb_add(&bar[XB_XCNT(b.x)], 1u);
    return b;
}
__device__ __forceinline__ void xcd_barrier_complete(unsigned* bar, unsigned x, unsigned& nloc, unsigned& nx) {
    const unsigned G = gridDim.x * gridDim.y * gridDim.z;
    unsigned sum, cnt, mine, sp = 0u;
    for (;;) {
        sum = 0u; cnt = 0u; mine = 0u;
#pragma unroll
        for (unsigned j = 0; j < 16; ++j) { const unsigned c = xb_ld(&bar[XB_XCNT(j)]); sum += c; cnt += (c > 0u) ? 1u : 0u; mine = (j == x) ? c : mine; }
        if (sum == G) break;
        __builtin_amdgcn_s_sleep(1);
        if ((++sp & 255u) == 0u) { if (xb_ld(&bar[XB_TMO])) break; if (sp > XB_SPIN_CAP) { atomicAdd(&bar[XB_TMO], 1u); break; } }
    }
    nloc = mine > 0u ? mine : 1u; nx = cnt > 0u ? cnt : 1u;
}

__device__ __forceinline__ void xcd_barrier(const XcdBarrier& b) {
    asm volatile("s_waitcnt vmcnt(0)" ::: "memory");
    __syncthreads();
    if (threadIdx.x == 0) {
        unsigned* bar = b.bar;
        __builtin_amdgcn_s_waitcnt(0);
        unsigned nloc = b.st[0], nx = b.st[1];
        if (nloc == 0u) { xcd_barrier_complete(bar, b.x, nloc, nx); b.st[0] = nloc; b.st[1] = nx; }
        const unsigned old = xb_add(&bar[XB_XSUB(b.x)], 1u);
        const unsigned gen = old / nloc;
        if (old + 1u == (gen + 1u) * nloc) {
            __builtin_amdgcn_fence(__ATOMIC_RELEASE, "agent");
            asm volatile("s_waitcnt vmcnt(0)" ::: "memory");
            const unsigned og = xb_add(&bar[XB_TOP], 1u);
            const unsigned tg = og / nx;
            if (og + 1u == (tg + 1u) * nx) xb_add(&bar[XB_TOPGEN], 1u);
            else XB_SPIN(xb_ld(&bar[XB_TOPGEN]) == tg, bar);
            __builtin_amdgcn_fence(__ATOMIC_ACQUIRE, "agent");
            xb_add(&bar[XB_XGEN(b.x)], 1u);
            asm volatile("s_waitcnt vmcnt(0)" ::: "memory");
        } else {
            XB_SPIN(xb_ld(&bar[XB_XGEN(b.x)]) == gen, bar);
            __builtin_amdgcn_fence(__ATOMIC_ACQUIRE, "agent");
            asm volatile("s_waitcnt vmcnt(0)" ::: "memory");
        }
    }
    __syncthreads();
}


constexpr int NWAVES = 8, NTHR = NWAVES * 64;
constexpr int BATCH = 4, SEQ = 2048, M = BATCH * SEQ, DM = 4096, NPROJ = 20480, AW = 2048, NH = 16, HD = 128, LBLK = 256, NBLK = 8;
constexpr int PH = 8, NKEY = 128, QD = 256, PHALF = 128, TOPK = 16, NEXP = 16384, PQW = PH * QD, NSLOT = PH * TOPK;
constexpr float NORM_EPS = 1e-6f;
constexpr int NGATE0 = 0;
constexpr unsigned long long SLABS_BF16 = 0x0ull, SLABS_I8 = 0x5432109876ull;
__host__ __device__ constexpr int slab_is_i8(int s) { return true; }
__host__ __device__ constexpr int slab_pos(int s) { return s >= 6 ? s - 6 : s + 4; }
constexpr float HQ_SCALE = 127.0f / 5.5f;
constexpr float WB8_SCALE = 127.0f * 45.254834f / 4.0f;
constexpr float W8_SCALE = 127.0f * 64.0f / 4.0f;
constexpr float U_STEP = 0.3352f / 64.0f;
constexpr float V_SCALE = 22.627417f;
typedef float f32x2v __attribute__((ext_vector_type(2)));
#ifndef MK_N_LAUNCHES
#define MK_N_LAUNCHES 1
#endif
constexpr int N_PHASES = 12;
#ifndef DUP_PHASE
#define DUP_PHASE (-1)
#endif
#ifndef P9_DUP_PART
#define P9_DUP_PART 0
#endif
#ifndef P9_VALU_REPS
#define P9_VALU_REPS 1
#endif
#ifndef GEMM_DUP
#define GEMM_DUP 0
#endif
#define GDUP(b) (((GEMM_DUP >> (b)) & 1) ? 2 : 1)
#ifndef PEER_SLICED
#define PEER_SLICED 1
#endif
#ifndef PHASE_MASK
#define PHASE_MASK 0xfff
#endif
constexpr int N_LAUNCHES = MK_N_LAUNCHES;

constexpr size_t MiB = 1u << 20;
constexpr size_t WS_CTL = 0, CTL_ZERO_BYTES = 1 * MiB;
constexpr size_t WS_WT_IN = 2 * MiB;
constexpr size_t WS_WT_BRA = WS_WT_IN + 160 * MiB;
constexpr size_t WS_WT_BRC = WS_WT_BRA + 16 * MiB;
constexpr size_t WS_WT_OUT = WS_WT_BRC + 16 * MiB;
constexpr size_t WS_WT_PQ = WS_WT_OUT + 32 * MiB;
constexpr size_t WS_UB = WS_WT_PQ + 16 * MiB;
constexpr size_t WS_VB = WS_UB + 128 * MiB;
constexpr size_t WS_HN = WS_VB + 128 * MiB;
constexpr size_t WS_PROJ = WS_HN + 64 * MiB;
constexpr size_t WS_ATT = WS_PROJ + 320 * MiB;
constexpr size_t WS_CONV = WS_ATT + 32 * MiB;
constexpr size_t WS_MRG = WS_CONV + 32 * MiB;
constexpr size_t WS_KMEAN = WS_MRG + 64 * MiB;
constexpr size_t WS_EIDX = WS_KMEAN + 1 * MiB;
constexpr size_t WS_EG = WS_EIDX + 4 * MiB;
constexpr size_t WS_KHI = WS_EG + 4 * MiB;
constexpr size_t WS_KLO = WS_KHI + 512 * 1024;
constexpr size_t WS_HN8 = WS_KLO + 512 * 1024;
constexpr size_t WS_SX = WS_HN8 + 32 * MiB;
constexpr size_t WS_END = WS_SX + 64 * 1024;
constexpr size_t WS_H1 = WS_PROJ;
constexpr size_t WS_QP = WS_PROJ + 128 * MiB;
constexpr size_t PROJ_TS = (size_t)M * AW;
static_assert(WS_QP + (size_t)M * PQW * 4 <= WS_ATT, "overlay fits");
constexpr int CW_BAR = 4096;
constexpr size_t WS_ROWCS = WS_CTL + 320 * 1024;
constexpr size_t WS_ROWSS = WS_CTL + 256 * 1024;

constexpr int RING_BYTES = 131072;
constexpr int LDSCTL_OFF = 155648, LDS_BYTES = LDSCTL_OFF + 1024;
static_assert(moba::LDS_BYTES <= LDSCTL_OFF, "LDS map");

#define GAS __attribute__((address_space(1)))
typedef unsigned short bf16;
typedef unsigned v4u __attribute__((ext_vector_type(4)));
typedef unsigned v2u __attribute__((ext_vector_type(2)));
typedef float f32x4 __attribute__((ext_vector_type(4)));
typedef __bf16 bf2_t __attribute__((ext_vector_type(2)));
#define LDS_WAIT() asm volatile("s_waitcnt lgkmcnt(0)" ::: "memory")
#define VM_WAIT() asm volatile("s_waitcnt vmcnt(0)" ::: "memory")
__device__ __forceinline__ unsigned f2bf(float f) { unsigned u = __builtin_bit_cast(unsigned, f); return (u + 0x7fffu + ((u >> 16) & 1u)) >> 16; }
__device__ __forceinline__ unsigned pk2(float lo, float hi) { return f2bf(lo) | (f2bf(hi) << 16); }
__device__ __forceinline__ float bflo(unsigned w) { return __uint_as_float(w << 16); }
__device__ __forceinline__ float bfhi(unsigned w) { return __uint_as_float(w & 0xffff0000u); }

struct Frame {
    LAS unsigned char* lds;
    int tid, lane, wave, vcu, G;
    float* out; unsigned char* ws;
};
__device__ __forceinline__ const float* lds_in_ptr(const Frame& F, int i) {
    volatile LAS unsigned* p = (volatile LAS unsigned*)(F.lds + LDSCTL_OFF + 128) + 2 * i; const unsigned lo = p[0], hi = p[1];
    return (const float*)(const GAS float*)(((unsigned long long)(unsigned)__builtin_amdgcn_readfirstlane((int)hi) << 32) | (unsigned long long)(unsigned)__builtin_amdgcn_readfirstlane((int)lo));
}
#define F_IN(i) lds_in_ptr(F, i)
#define F_WT_IN ((bf16*)(F.ws + WS_WT_IN))
#define F_WT_BRA ((bf16*)(F.ws + WS_WT_BRA))
#define F_WT_BRC ((bf16*)(F.ws + WS_WT_BRC))
#define F_WT_OUT ((bf16*)(F.ws + WS_WT_OUT))
#define F_WT_PQ ((bf16*)(F.ws + WS_WT_PQ))
#define F_U4 ((unsigned char*)(F.ws + WS_UB))
#define F_V4 ((unsigned char*)(F.ws + WS_VB))
#define F_HN ((bf16*)(F.ws + WS_HN))
#define F_PROJ ((bf16*)(F.ws + WS_PROJ))
#define F_ATT ((bf16*)(F.ws + WS_ATT))
#define F_CONV ((bf16*)(F.ws + WS_CONV))
#define F_MRG ((bf16*)(F.ws + WS_MRG))
#define F_KMEAN ((float*)(F.ws + WS_KMEAN))
#define F_EIDX ((int*)(F.ws + WS_EIDX))
#define F_EG ((float*)(F.ws + WS_EG))
#define F_H1 ((float*)(F.ws + WS_H1))
#define F_QH ((bf16*)(F.ws + WS_QP))
#define F_QL ((bf16*)(F.ws + WS_QP + 32 * MiB))
#define F_ROWSS ((float*)(F.ws + WS_ROWSS))
#define F_ROWCS ((int*)(F.ws + WS_ROWCS))
#define F_HN8 ((unsigned char*)(F.ws + WS_HN8))
#define F_HQ8 ((unsigned char*)(F.ws + WS_HN))
#define F_WPQ8 ((unsigned char*)(F.ws + WS_WT_PQ))
#define F_SX ((float*)(F.ws + WS_SX))
#define F_W8T ((unsigned char*)(F.ws + WS_WT_IN + (size_t)NGATE0 * DM * 2))
#define F_KHI ((bf16*)(F.ws + WS_KHI))
#define F_KLO ((bf16*)(F.ws + WS_KLO))

__device__ __forceinline__ float wave_sum(float v) {
#pragma unroll
    for (int o = 1; o < 64; o <<= 1) v += __shfl_xor(v, o);
    return v;
}
__device__ __forceinline__ void p0_transpose_item(const float* W, int K, int N, bf16* WT, LAS float* scr, int item, int lane) {
    const int nblk = N / 32, kb = item / nblk, nb = item % nblk, k0 = 64 * kb, n0 = 32 * nb;
    { const GAS float* wb = (const GAS float*)W + (size_t)k0 * N + n0; const unsigned lo = (unsigned)((lane >> 5) * N + (lane & 31)); float wv[32];
#pragma unroll
      for (int i = 0; i < 32; ++i) { wv[i] = wb[lo]; wb += 2 * N; }
#pragma unroll
      for (int i = 0; i < 32; ++i) scr[(2 * i + (lane >> 5)) * 33 + (lane & 31)] = wv[i]; }
    LDS_WAIT(); asm volatile("" ::: "memory");
    const int c = lane & 7;
#pragma unroll
    for (int j = 0; j < 4; ++j) { const int n = (lane >> 3) + 8 * j; const LAS float* s = scr + (8 * c) * 33 + n;
        v4u o; o.x = pk2(s[0 * 33], s[1 * 33]); o.y = pk2(s[2 * 33], s[3 * 33]); o.z = pk2(s[4 * 33], s[5 * 33]); o.w = pk2(s[6 * 33], s[7 * 33]);
        *(GAS v4u*)(WT + (size_t)(n0 + n) * K + k0 + 8 * c) = o; }
    LDS_WAIT(); asm volatile("" ::: "memory");
}
__device__ __forceinline__ void rms_row_to_bf16(const float* xrow, const float* gain, bf16* orow, int lane) {
    const GAS f32x4* xr = (const GAS f32x4*)xrow + lane; const GAS f32x4* gr = (const GAS f32x4*)gain + lane;
    f32x4 v[16]; float s = 0.f;
#pragma unroll
    for (int j = 0; j < 16; ++j) { v[j] = xr[64 * j]; s += (v[j].x * v[j].x + v[j].y * v[j].y) + (v[j].z * v[j].z + v[j].w * v[j].w); }
    const float r = 1.0f / sqrtf(wave_sum(s) * (1.0f / DM) + NORM_EPS);
    GAS v2u* o8 = (GAS v2u*)orow + lane;
#pragma unroll
    for (int j = 0; j < 16; ++j) { const f32x4 g = gr[64 * j]; v2u w; w.x = pk2(v[j].x * r * g.x, v[j].y * r * g.y); w.y = pk2(v[j].z * r * g.z, v[j].w * r * g.w); o8[64 * j] = w; }
}


__device__ __forceinline__ void p0_transpose_item_i8(const float* W, int K, int N, unsigned char* WT8, int n_lo, float scale, LAS float* scr, int item, int lane) {
    const int nblk = N / 32, kb = item / nblk, nb = item % nblk, k0 = 64 * kb, n0 = 32 * nb;
    { const GAS float* wb = (const GAS float*)W + (size_t)k0 * N + n0; const unsigned lo = (unsigned)((lane >> 5) * N + (lane & 31)); float wv[32];
#pragma unroll
      for (int i = 0; i < 32; ++i) { wv[i] = wb[lo]; wb += 2 * N; }
#pragma unroll
      for (int i = 0; i < 32; ++i) scr[(2 * i + (lane >> 5)) * 33 + (lane & 31)] = wv[i]; }
    LDS_WAIT(); asm volatile("" ::: "memory");
    const int c = lane & 7;
#pragma unroll
    for (int j = 0; j < 4; ++j) { const int n = (lane >> 3) + 8 * j; const LAS float* s = scr + (8 * c) * 33 + n; unsigned q[8];
#pragma unroll
        for (int i = 0; i < 8; ++i) { int v = (int)rintf(s[i * 33] * scale); v = v < -127 ? -127 : (v > 127 ? 127 : v); q[i] = (unsigned)(v & 255); }
        v2u o; o.x = q[0] | (q[1] << 8) | (q[2] << 16) | (q[3] << 24); o.y = q[4] | (q[5] << 8) | (q[6] << 16) | (q[7] << 24);
        *(GAS v2u*)(WT8 + (size_t)(n0 - n_lo + n) * K + k0 + 8 * c) = o; }
    LDS_WAIT(); asm volatile("" ::: "memory");
}
__device__ __forceinline__ void p0_transpose_any(const float* W, int K, int N, unsigned char* dst, int drow, bool is8, float qs, LAS float* scr, int item, int lane) {
    const int nblk = N / 32, kb = item / nblk, nb = item - kb * nblk, k0 = 128 * kb, n0 = 32 * nb;
    { const GAS float* wb = (const GAS float*)W + (size_t)k0 * N + n0; const unsigned lo = (unsigned)((lane >> 5) * N + (lane & 31)); float wv[64];
#pragma unroll
      for (int i = 0; i < 64; ++i) { wv[i] = __builtin_nontemporal_load(wb + lo); wb += 2 * N; }
#pragma unroll
      for (int i = 0; i < 64; ++i) scr[(2 * i + (lane >> 5)) * 33 + (lane & 31)] = wv[i]; }
    LDS_WAIT(); asm volatile("" ::: "memory");
    const int c = lane & 7;
#pragma unroll
    for (int j = 0; j < 4; ++j) { const int n = (lane >> 3) + 8 * j; const LAS float* s = scr + (16 * c) * 33 + n; float f[16];
#pragma unroll
        for (int i = 0; i < 16; ++i) f[i] = s[i * 33];
        const size_t row = (size_t)(n0 + n + drow);
        if (is8) { unsigned q[16];
#pragma unroll
            for (int i = 0; i < 16; ++i) { int v = (int)rintf(f[i] * qs); v = v < -127 ? -127 : (v > 127 ? 127 : v); q[i] = (unsigned)(v & 255); }
            v4u o;
#pragma unroll
            for (int w = 0; w < 4; ++w) o[w] = q[4 * w] | (q[4 * w + 1] << 8) | (q[4 * w + 2] << 16) | (q[4 * w + 3] << 24);
            *(GAS v4u*)(dst + row * K + k0 + 16 * c) = o;
        } else { v4u o0, o1;
#pragma unroll
            for (int w = 0; w < 4; ++w) { o0[w] = pk2(f[2 * w], f[2 * w + 1]); o1[w] = pk2(f[8 + 2 * w], f[8 + 2 * w + 1]); }
            GAS v4u* op = (GAS v4u*)(dst + (row * K + k0 + 16 * c) * 2); op[0] = o0; op[1] = o1; } }
    LDS_WAIT(); asm volatile("" ::: "memory");
}
__device__ __forceinline__ void rms_row_to_bf16_i8(const float* xrow, const float* gain, bf16* orow, unsigned char* x8row, float* sxp, int lane) {
    const GAS f32x4* xr = (const GAS f32x4*)xrow + lane; const GAS f32x4* gr = (const GAS f32x4*)gain + lane;
    f32x4 v[16]; float s = 0.f;
#pragma unroll
    for (int j = 0; j < 16; ++j) { v[j] = __builtin_nontemporal_load(xr + 64 * j); s += (v[j].x * v[j].x + v[j].y * v[j].y) + (v[j].z * v[j].z + v[j].w * v[j].w); }
    const float r = 1.0f / sqrtf(wave_sum(s) * (1.0f / DM) + NORM_EPS);
    GAS v2u* o8 = (GAS v2u*)orow + lane; float amax = 0.f;
#pragma unroll
    for (int j = 0; j < 16; ++j) { const f32x4 g = gr[64 * j]; v[j].x = v[j].x * r * g.x; v[j].y = v[j].y * r * g.y; v[j].z = v[j].z * r * g.z; v[j].w = v[j].w * r * g.w;
        if (NGATE0 > 0) { v2u w; w.x = pk2(v[j].x, v[j].y); w.y = pk2(v[j].z, v[j].w); o8[64 * j] = w; }
        amax = fmaxf(fmaxf(amax, fmaxf(fabsf(v[j].x), fabsf(v[j].y))), fmaxf(fabsf(v[j].z), fabsf(v[j].w))); }
#pragma unroll
    for (int o = 1; o < 64; o <<= 1) amax = fmaxf(amax, __shfl_xor(amax, o));
    amax = fmaxf(amax, 1e-20f); const float isx = 127.0f / amax;
    GAS unsigned* x8 = (GAS unsigned*)x8row + lane;
#pragma unroll
    for (int j = 0; j < 16; ++j) { int q0 = (int)rintf(v[j].x * isx), q1 = (int)rintf(v[j].y * isx), q2 = (int)rintf(v[j].z * isx), q3 = (int)rintf(v[j].w * isx);
        q0 = q0 < -127 ? -127 : (q0 > 127 ? 127 : q0); q1 = q1 < -127 ? -127 : (q1 > 127 ? 127 : q1); q2 = q2 < -127 ? -127 : (q2 > 127 ? 127 : q2); q3 = q3 < -127 ? -127 : (q3 > 127 ? 127 : q3);
        x8[64 * j] = (unsigned)(q0 & 255) | ((unsigned)(q1 & 255) << 8) | ((unsigned)(q2 & 255) << 16) | ((unsigned)(q3 & 255) << 24); }
    if (lane == 0) *sxp = amax * (1.0f / 127.0f);
}

constexpr int TBL_NCH = (int)((size_t)NEXP * DM / 2048);
__device__ __forceinline__ void tbl_load(const float* pu, const float* pv, int c, int lane, f32x4 (&a)[8]) {
    const bool isu = c < TBL_NCH; const int cc = isu ? c : c - TBL_NCH;
    const GAS f32x4* src = (const GAS f32x4*)((isu ? pu : pv) + (size_t)cc * 2048) + lane;
#pragma unroll
    for (int j = 0; j < 8; ++j) a[j] = __builtin_nontemporal_load(src + j * 64);
}
__device__ __forceinline__ void tbl_store(unsigned char* u4, unsigned char* v4t, int c, int lane, const f32x4 (&a)[8]) {
    const bool isu = c < TBL_NCH; const int cc = isu ? c : c - TBL_NCH;
    GAS v4u* dst = (GAS v4u*)((isu ? u4 : v4t) + (size_t)cc * 1024) + lane;
    v4u o;
    if (isu) {
#pragma unroll
        for (int m = 0; m < 4; ++m) { unsigned w = 0u;
#pragma unroll
            for (int i = 0; i < 8; ++i) { const float v = a[2 * m + (i >> 2)][i & 3]; int n = (int)floorf(v * (1.0f / U_STEP)) + 8; n = n < 0 ? 0 : (n > 15 ? 15 : n); w |= (unsigned)n << (4 * i); }
            o[m] = w; }
    } else {
#pragma unroll
        for (int m = 0; m < 4; ++m) { unsigned w = 0u;
            w = __builtin_amdgcn_cvt_scalef32_pk_fp4_f32(w, a[2 * m].x * V_SCALE, a[2 * m].y * V_SCALE, 1.0f, 0); w = __builtin_amdgcn_cvt_scalef32_pk_fp4_f32(w, a[2 * m].z * V_SCALE, a[2 * m].w * V_SCALE, 1.0f, 1);
            w = __builtin_amdgcn_cvt_scalef32_pk_fp4_f32(w, a[2 * m + 1].x * V_SCALE, a[2 * m + 1].y * V_SCALE, 1.0f, 2); w = __builtin_amdgcn_cvt_scalef32_pk_fp4_f32(w, a[2 * m + 1].z * V_SCALE, a[2 * m + 1].w * V_SCALE, 1.0f, 3);
            o[m] = w; }
    }
    dst[0] = o;
}
constexpr int TBL_PER_CALL = 4;
__device__ __forceinline__ void tbl_rest(const float* pu, const float* pv, unsigned char* u4, unsigned char* v4t, int gw, int NGW, int lane, int done_units) {
    for (int c = done_units * NGW * TBL_PER_CALL + gw; c < 2 * TBL_NCH; c += NGW) { f32x4 a[8]; tbl_load(pu, pv, c, lane, a); tbl_store(u4, v4t, c, lane, a); }
}
#if PEER_SLICED
__device__ __forceinline__ void p0_tables(Frame& F, LAS unsigned* scr);
#endif
__device__ __forceinline__ void p0_prologue(Frame& F) {
    const int gw = F.vcu * NWAVES + F.wave, NGW = F.G * NWAVES, lane = F.lane;
#if PEER_SLICED
    p0_tables(F, (LAS unsigned*)(F.lds + F.wave * 16384));
#else
    { const float* pu = F_IN(13); const float* pv = F_IN(14); tbl_rest(pu, pv, F_U4, F_V4, gw, NGW, lane, 0); }
#endif
    LAS float* scr = (LAS float*)(F.lds + F.wave * 17408);
    constexpr int I_IN = (DM / 128) * (NPROJ / 32), I_BR = (AW / 128) * (DM / 32), I_OUT = (DM / 128) * (DM / 32), I_PQ = (DM / 128) * (PQW / 32);
    constexpr int NITEMS = I_IN + 2 * I_BR + I_OUT + I_PQ;
    for (int it = gw; it < NITEMS; it += NGW) {
        int r = it, widx, K_, N_, drow = 0; size_t doff; bool is8 = false; float qs = W8_SCALE;
        if (r < I_IN) { const int n0_ = (r % (NPROJ / 32)) * 32, sl_ = n0_ / AW; drow = (slab_pos(sl_) - sl_) * AW;
            widx = 2; K_ = DM; N_ = NPROJ; is8 = slab_is_i8(sl_) != 0; doff = is8 ? WS_WT_IN + (size_t)NGATE0 * DM * 2 : WS_WT_IN; }
        else if ((r -= I_IN) < I_BR) { widx = 5; K_ = AW; N_ = DM; doff = WS_WT_BRA; is8 = true; qs = WB8_SCALE; }
        else if ((r -= I_BR) < I_BR) { widx = 6; K_ = AW; N_ = DM; doff = WS_WT_BRC; }
        else if ((r -= I_BR) < I_OUT) { widx = 9; K_ = DM; N_ = DM; doff = WS_WT_OUT; }
        else { r -= I_OUT; widx = 11; K_ = DM; N_ = PQW; doff = WS_WT_PQ; is8 = true; }
        p0_transpose_any(F_IN(widx), K_, N_, F.ws + doff, drow, is8, qs, scr, r, lane);
    }
    { const int gt = F.vcu * NTHR + F.tid, NGT = F.G * NTHR;
      for (int i = gt; i < PH * 2 * NKEY * PHALF / 2; i += NGT) { const float2 kv = *(const float2*)(F_IN(12) + 2 * (size_t)i);
          const unsigned h = pk2(kv.x, kv.y); const unsigned l = pk2(kv.x - bflo(h), kv.y - bfhi(h));
          ((unsigned*)F_KHI)[i] = h; ((unsigned*)F_KLO)[i] = l; } }
    for (int m = gw; m < M; m += NGW) rms_row_to_bf16_i8(F_IN(0) + (size_t)m * DM, F_IN(1), F_HN + (size_t)m * DM, F_HN8 + (size_t)m * DM, F_SX + m, lane);
}

__device__ __forceinline__ void p2_kmean_conv(Frame& F) {
    const int gw = F.vcu * NWAVES + F.wave, NGW = F.G * NWAVES, lane = F.lane;
    const bf16* PK = F_PROJ + 1 * PROJ_TS;
    for (int pr = F.vcu; pr < BATCH * NBLK * NH / 2; pr += F.G) {
        const int it = 2 * pr + (F.wave >> 2), q = F.wave & 3, h = it % NH, n = (it / NH) % NBLK, b = it / (NH * NBLK), c = lane & 15, rg = lane >> 4;
        const bf16* kp = PK + (size_t)(b * SEQ + n * LBLK + q * 64 + rg) * AW + h * HD + 8 * c;
        float s[8];
#pragma unroll
        for (int e = 0; e < 8; ++e) s[e] = 0.f;
#pragma unroll
        for (int i = 0; i < 16; ++i) { const v4u w = *(const GAS v4u*)(kp + (size_t)(4 * i) * AW);
            s[0] += bflo(w.x); s[1] += bfhi(w.x); s[2] += bflo(w.y); s[3] += bfhi(w.y); s[4] += bflo(w.z); s[5] += bfhi(w.z); s[6] += bflo(w.w); s[7] += bfhi(w.w); }
#pragma unroll
        for (int e = 0; e < 8; ++e) { s[e] += __shfl_xor(s[e], 16); s[e] += __shfl_xor(s[e], 32); }
        LAS float* kq = (LAS float*)F.lds;
        __syncthreads();
        if (rg == 0) { *(LAS f32x4*)(kq + F.wave * 128 + 8 * c) = (f32x4){s[0], s[1], s[2], s[3]}; *(LAS f32x4*)(kq + F.wave * 128 + 8 * c + 4) = (f32x4){s[4], s[5], s[6], s[7]}; }
        __syncthreads();
        if (F.tid < 256) { const int ii = F.tid >> 7, d = F.tid & 127, it2 = 2 * pr + ii, h2 = it2 % NH, n2 = (it2 / NH) % NBLK, b2 = it2 / (NH * NBLK);
            const float tot = ((kq[(4 * ii) * 128 + d] + kq[(4 * ii + 1) * 128 + d]) + kq[(4 * ii + 2) * 128 + d]) + kq[(4 * ii + 3) * 128 + d];
            F_KMEAN[((size_t)(b2 * NH + h2) * NBLK + n2) * HD + d] = tot * (1.0f / LBLK); }
    }
    const bf16* PCB = F_PROJ + 3 * PROJ_TS; const bf16* PCC = F_PROJ + 4 * PROJ_TS; const bf16* PCU = F_PROJ + 5 * PROJ_TS;
    constexpr int CHUNK = 16, NCG = AW / 8, NITEM = (M / CHUNK) * NCG;
    const int gt = F.vcu * NTHR + F.tid, NGT = F.G * NTHR;
    for (int it = gt; it < NITEM; it += NGT) {
        const int cg = it % NCG, ch = it / NCG, t0 = ch * CHUNK, c0 = cg * 8;
        float w0[8], w1[8], w2[8], bb[8], g1[8], g2[8];
#pragma unroll
        for (int e = 0; e < 8; ++e) { w0[e] = F_IN(3)[c0 + e]; w1[e] = F_IN(3)[AW + c0 + e]; w2[e] = F_IN(3)[2 * AW + c0 + e]; bb[e] = F_IN(4)[c0 + e]; g1[e] = 0.f; g2[e] = 0.f; }
        if ((t0 % SEQ) != 0) {
            const v4u a1 = *(const GAS v4u*)(PCC + (size_t)(t0 - 1) * AW + c0), u1 = *(const GAS v4u*)(PCU + (size_t)(t0 - 1) * AW + c0);
            const v4u a2 = *(const GAS v4u*)(PCC + (size_t)(t0 - 2) * AW + c0), u2 = *(const GAS v4u*)(PCU + (size_t)(t0 - 2) * AW + c0);
#pragma unroll
            for (int q = 0; q < 4; ++q) { g1[2 * q] = bflo(a1[q]) * bflo(u1[q]); g1[2 * q + 1] = bfhi(a1[q]) * bfhi(u1[q]); g2[2 * q] = bflo(a2[q]) * bflo(u2[q]); g2[2 * q + 1] = bfhi(a2[q]) * bfhi(u2[q]); }
        }
#pragma unroll 4
        for (int t = t0; t < t0 + CHUNK; ++t) {
            const v4u cb = *(const GAS v4u*)(PCB + (size_t)t * AW + c0), a0 = *(const GAS v4u*)(PCC + (size_t)t * AW + c0), u0 = *(const GAS v4u*)(PCU + (size_t)t * AW + c0);
            float g0[8], z[8];
#pragma unroll
            for (int q = 0; q < 4; ++q) { g0[2 * q] = bflo(a0[q]) * bflo(u0[q]); g0[2 * q + 1] = bfhi(a0[q]) * bfhi(u0[q]); }
#pragma unroll
            for (int e = 0; e < 8; ++e) { const float y = w0[e] * g2[e] + w1[e] * g1[e] + w2[e] * g0[e] + bb[e]; const float cbv = (e & 1) ? bfhi(cb[e >> 1]) : bflo(cb[e >> 1]); z[e] = cbv * y; g2[e] = g1[e]; g1[e] = g0[e]; }
            v4u o; o.x = pk2(z[0], z[1]); o.y = pk2(z[2], z[3]); o.z = pk2(z[4], z[5]); o.w = pk2(z[6], z[7]);
            *(GAS v4u*)(F_CONV + (size_t)t * AW + c0) = o;
        }
    }
}

__device__ __forceinline__ moba::BlockRef attn_ref(const Frame& F, int b, int h, int qb) {
    moba::BlockRef r;
    const size_t qoff = (size_t)(b * SEQ + qb * LBLK) * AW + h * HD, koff = (size_t)(b * SEQ) * AW + h * HD;
    r.Q = F_PROJ + qoff; r.K = F_PROJ + PROJ_TS + koff; r.V = F_PROJ + 2 * PROJ_TS + koff; r.O = (unsigned char*)F_ATT + qoff;
    r.kmean = F_KMEAN + (size_t)(b * NH + h) * NBLK * HD; r.relh = F_IN(8) + h; r.P0 = qb * LBLK;
    return r;
}
__device__ __forceinline__ void p3_attention(Frame& F, char* lds) {
    for (int L = F.vcu; L < BATCH * NH * 4; L += F.G) {
        const int bh = L >> 2, y = L & 3, b = bh / NH, h = bh % NH;
        moba::Seam S;
        moba::BlockRef cur = attn_ref(F, b, h, y);
        const moba::BlockRef heavy = attn_ref(F, b, h, NBLK - 1 - y);
        moba::moba_prime(cur, lds, S);
#pragma unroll 1
        for (int pass = 0; pass < 2; ++pass) {
            moba::moba_block(cur, heavy, lds, S);
            cur = heavy;
        }
    }
}

typedef float f32x16 __attribute__((ext_vector_type(16)));
typedef short bf16x8v __attribute__((ext_vector_type(8)));
__device__ __forceinline__ unsigned f2key(float f) { const unsigned u = __float_as_uint(f); return u ^ ((unsigned)((int)u >> 31) | 0x80000000u); }
__device__ __forceinline__ float key2f(unsigned k) { return __uint_as_float((k & 0x80000000u) ? (k ^ 0x80000000u) : ~k); }
__device__ __forceinline__ unsigned umed3(unsigned a, unsigned b, unsigned c) { unsigned d; asm("v_med3_u32 %0, %1, %2, %3" : "=v"(d) : "v"(a), "v"(b), "v"(c)); return d; }
__device__ __forceinline__ void key_insert(unsigned (&tk)[16], unsigned x) {
#pragma unroll
    for (int s = 15; s >= 1; --s) tk[s] = umed3(tk[s - 1], tk[s], x);
    tk[0] = tk[0] > x ? tk[0] : x;
}
constexpr int P8_KEYS = 32768, P8_KPITCH = 272;
constexpr int PK_LIST = 0;
__device__ __forceinline__ void p8_peer_topk(Frame& F) {
    const int gw = F.vcu * NWAVES + F.wave, NGW = F.G * NWAVES, lane = F.lane, r32 = lane & 31, hi = lane >> 5;
    LAS int* LST = (LAS int*)(F.lds + PK_LIST) + F.wave * 1024;
    for (int task = gw; task < (M / 32) * PH; task += NGW) {
        const int h = (task >> 3) % PH, t0 = ((task >> 6) * 8 + (task & 7)) * 32;
        unsigned kl[2][16];
#pragma unroll
        for (int j = 0; j < 2; ++j) {
            bf16x8v qh[8];
            const size_t qoff = (size_t)(t0 + r32) * PQW + h * QD + j * PHALF + hi * 8;
#pragma unroll
            for (int d0 = 0; d0 < 8; ++d0) { qh[d0] = *(const GAS bf16x8v*)(F_QH + qoff + d0 * 16); }
            __syncthreads();
            { const GAS v4u* sh = (const GAS v4u*)(F_KHI + (size_t)(h * 2 + j) * NKEY * PHALF); const GAS v4u* sl = (const GAS v4u*)(F_KLO + (size_t)(h * 2 + j) * NKEY * PHALF);
              v4u th[4], tl[4];
#pragma unroll
              for (int i = 0; i < 4; ++i) { th[i] = sh[F.tid + 512 * i]; tl[i] = sl[F.tid + 512 * i]; }
#pragma unroll
              for (int i = 0; i < 4; ++i) { const int c = F.tid + 512 * i, off = (c >> 4) * P8_KPITCH + (c & 15) * 16; *(LAS v4u*)(F.lds + P8_KEYS + off) = th[i]; *(LAS v4u*)(F.lds + P8_KEYS + NKEY * P8_KPITCH + off) = tl[i]; } }
            __syncthreads();
            f32x16 p[4];
#pragma unroll
            for (int blk = 0; blk < 4; ++blk) { p[blk] = f32x16{};
                const int koff = (blk * 32 + r32) * P8_KPITCH + hi * 16;
#pragma unroll
                for (int d0 = 0; d0 < 8; ++d0) { const bf16x8v kh = *(const LAS bf16x8v*)(F.lds + P8_KEYS + koff + d0 * 32), kl_ = *(const LAS bf16x8v*)(F.lds + P8_KEYS + NKEY * P8_KPITCH + koff + d0 * 32);
                    p[blk] = __builtin_amdgcn_mfma_f32_32x32x16_bf16(kl_, qh[d0], p[blk], 0, 0, 0);
                    p[blk] = __builtin_amdgcn_mfma_f32_32x32x16_bf16(kh, qh[d0], p[blk], 0, 0, 0); } }
            unsigned tk[16];
#pragma unroll
            for (int s = 0; s < 16; ++s) tk[s] = 0u;
#pragma unroll
            for (int blk = 0; blk < 4; ++blk)
#pragma unroll
                for (int r = 0; r < 16; ++r) { const int kidx = blk * 32 + (r & 3) + 8 * (r >> 2) + 4 * hi; key_insert(tk, (f2key(p[blk][r]) & ~127u) | (unsigned)(127 - kidx)); }
            unsigned pk[16];
#pragma unroll
            for (int s = 0; s < 16; ++s) pk[s] = (unsigned)__shfl_xor((int)tk[s], 32);
#pragma unroll
            for (int s = 0; s < 16; ++s) key_insert(tk, pk[s]);
#pragma unroll
            for (int s = 0; s < 16; ++s) kl[j][s] = tk[s];
        }
        if (hi == 0) {
#pragma unroll
            for (int s = 0; s < 16; ++s) { LST[r32 * 32 + s] = 127 - (int)(kl[0][s] & 127u); LST[r32 * 32 + 16 + s] = 127 - (int)(kl[1][s] & 127u); } }
        float v1[16], v2[16];
#pragma unroll
        for (int s = 0; s < 16; ++s) { v1[s] = key2f(kl[0][s] & ~127u); v2[s] = key2f(kl[1][s] & ~127u); }
        unsigned tk[16];
#pragma unroll
        for (int s = 0; s < 16; ++s) tk[s] = 0u;
#pragma unroll
        for (int a = 0; a < 16; ++a)
#pragma unroll
            for (int b = 0; b < 16; ++b) if ((a + 1) * (b + 1) <= 16) key_insert(tk, (f2key(v1[a] + v2[b]) & ~255u) | (unsigned)(255 - (a * 16 + b)));
        float ex[16], den = 0.f; const float mx = key2f(tk[0] & ~255u);
#pragma unroll
        for (int s = 0; s < 16; ++s) { ex[s] = __expf(key2f(tk[s] & ~255u) - mx); den += ex[s]; }
        const float inv = 1.0f / den;
        asm volatile("s_waitcnt lgkmcnt(0)" ::: "memory");
        int* eo = F_EIDX + (size_t)(t0 + r32) * NSLOT + h * TOPK + hi * 8; float* go = F_EG + (size_t)(t0 + r32) * NSLOT + h * TOPK + hi * 8;
        int ev[8]; float gv8[8];
#pragma unroll
        for (int i = 0; i < 8; ++i) { const unsigned kk = hi ? tk[8 + i] : tk[i]; gv8[i] = (hi ? ex[8 + i] : ex[i]) * inv;
            const int flat = 255 - (int)(kk & 255u), a = flat >> 4, b = flat & 15;
            ev[i] = LST[r32 * 32 + a] * NKEY + LST[r32 * 32 + 16 + b]; }
        { typedef int i32x4v __attribute__((ext_vector_type(4)));
          *(GAS i32x4v*)eo = (i32x4v){ev[0], ev[1], ev[2], ev[3]}; *(GAS i32x4v*)(eo + 4) = (i32x4v){ev[4], ev[5], ev[6], ev[7]};
          *(GAS f32x4*)go = (f32x4){gv8[0], gv8[1], gv8[2], gv8[3]}; *(GAS f32x4*)(go + 4) = (f32x4){gv8[4], gv8[5], gv8[6], gv8[7]}; }
        asm volatile("s_waitcnt lgkmcnt(0)" ::: "memory");
    }
}

__device__ __forceinline__ float gelu_exact(float a) { return 0.5f * a * (1.0f + erff(a * 0.70710678118654752f)); }
typedef _Float16 h2v __attribute__((ext_vector_type(2)));
__device__ __forceinline__ int dpp_addi(int v, int which) {
    int m;
    if (which == 0) m = __builtin_amdgcn_update_dpp(0, v, 0xB1, 0xF, 0xF, false);
    else if (which == 1) m = __builtin_amdgcn_update_dpp(0, v, 0x4E, 0xF, 0xF, false);
    else if (which == 2) m = __builtin_amdgcn_update_dpp(0, v, 0x141, 0xF, 0xF, false);
    else m = __builtin_amdgcn_update_dpp(0, v, 0x140, 0xF, 0xF, false);
    return v + m;
}
__device__ __forceinline__ int wave_sumi(int v) {
#pragma unroll
    for (int o = 1; o < 64; o <<= 1) v += __shfl_xor(v, o);
    return v;
}
constexpr float ACC_SCALE = 64.f;
__device__ __forceinline__ void p9_peer_final(Frame& F) {
    const int gw = F.vcu * NWAVES + F.wave, NGW = F.G * NWAVES, lane = F.lane;
    const float* nfp = F_IN(15);
    for (int t = gw; t < M; t += NGW) {
        const int e0 = F_EIDX[(size_t)t * NSLOT + lane], e1 = F_EIDX[(size_t)t * NSLOT + 64 + lane];
        const float gt0 = F_EG[(size_t)t * NSLOT + lane], gt1 = F_EG[(size_t)t * NSLOT + 64 + lane];
        int xlo[2][4], xhi[2][4]; int csum = 0; const float sx = 1.0f / HQ_SCALE;
#pragma unroll
        for (int c2 = 0; c2 < 2; ++c2)
#pragma unroll
            for (int m = 0; m < 4; ++m) { const unsigned d0 = *(const GAS unsigned*)(F_HQ8 + (size_t)t * DM + c2 * 2048 + (2 * m) * 256 + lane * 4), d1 = *(const GAS unsigned*)(F_HQ8 + (size_t)t * DM + c2 * 2048 + (2 * m + 1) * 256 + lane * 4);
                xlo[c2][m] = (int)((d0 & 0xFFu) | ((d0 >> 8) & 0xFF00u) | ((d1 & 0xFFu) << 16) | ((d1 << 8) & 0xFF000000u));
                xhi[c2][m] = (int)(((d0 >> 8) & 0xFFu) | ((d0 >> 16) & 0xFF00u) | ((d1 << 8) & 0xFF0000u) | (d1 & 0xFF000000u));
                csum = __builtin_amdgcn_sdot4((int)d0, 0x01010101, csum, false); csum = __builtin_amdgcn_sdot4((int)d1, 0x01010101, csum, false); }
        const float ctot = (float)wave_sumi(csum);
        unsigned XL[2][4], XH[2][4];
#pragma unroll
        for (int c2 = 0; c2 < 2; ++c2)
#pragma unroll
            for (int m = 0; m < 4; ++m) { const unsigned lo_ = (unsigned)xlo[c2][m], hi_ = (unsigned)xhi[c2][m];
                XL[c2][m] = (lo_ & 0x0F0F0F0Fu) | ((hi_ & 0x0F0F0F0Fu) << 4); XH[c2][m] = (((lo_ >> 4) & 0x0F0F0F0Fu) | (hi_ & 0xF0F0F0F0u)) ^ 0x88888888u; }
        float a0 = 0.f, a1 = 0.f;
#define P9_SLOT_E(s_) __builtin_amdgcn_readlane((s_) < 64 ? e0 : e1, (s_) & 63)
#define P9_LOADG(buf, TAB, g) do { _Pragma("unroll") for (int r_ = 0; r_ < 4; ++r_) { const int e_ = P9_SLOT_E(4 * (g) + r_); \
            const GAS v4u* p_ = (const GAS v4u*)((TAB) + (size_t)e_ * (DM / 2)) + lane; buf[r_][0] = p_[0]; buf[r_][1] = p_[64]; } } while (0)
#define P9_DOTG(buf, g) do { int sr[4]; \
            _Pragma("unroll") for (int r_ = 0; r_ < 4; ++r_) { unsigned sl_ = 0u, sh_ = 0u, sn_ = 0u; \
                _Pragma("unroll") for (int c2 = 0; c2 < 2; ++c2) _Pragma("unroll") for (int m = 0; m < 4; ++m) { const unsigned w = buf[r_][c2][m]; \
                    sl_ = __builtin_amdgcn_udot8(w, XL[c2][m], sl_, false); sh_ = __builtin_amdgcn_udot8(w, XH[c2][m], sh_, false); sn_ = __builtin_amdgcn_udot8(w, 0x11111111u, sn_, false); } \
                int s_ = 16 * ((int)sh_ - 8 * (int)sn_) + (int)sl_;                            \
                s_ = dpp_addi(s_, 0); s_ = dpp_addi(s_, 1); s_ = dpp_addi(s_, 2); s_ = dpp_addi(s_, 3); sr[r_] = s_; } \
            int v_ = (lane & 2) ? ((lane & 1) ? sr[3] : sr[2]) : ((lane & 1) ? sr[1] : sr[0]); \
            v_ += __shfl_xor(v_, 16); v_ += __shfl_xor(v_, 32); \
            _Pragma("unroll") for (int r_ = 0; r_ < 4; ++r_) { const int s_ = 4 * (g) + r_; const float tot_ = (float)__builtin_amdgcn_readlane(v_, r_); \
                if (lane == (s_ & 63)) { if (s_ < 64) a0 = tot_; else a1 = tot_; } } } while (0)
        for (int urep_ = 0; urep_ < (P9_DUP_PART == 1 ? 2 : 1); ++urep_)
        { v4u wA[4][2], wB[4][2], wC[4][2];
          P9_LOADG(wA, F_U4, 0); P9_LOADG(wB, F_U4, 1);
#pragma unroll 1
          for (int g = 0; g < 30; g += 3) {
              P9_LOADG(wC, F_U4, g + 2); P9_DOTG(wA, g);
              P9_LOADG(wA, F_U4, g + 3); P9_DOTG(wB, g + 1);
              P9_LOADG(wB, F_U4, g + 4); P9_DOTG(wC, g + 2);
          }
          P9_DOTG(wA, 30); P9_DOTG(wB, 31); }
#ifdef DBG_NO_PEER
        const float act0 = 0.f * a0 * gt0, act1 = 0.f * a1 * gt1;
#else
        const float ua = U_STEP * sx * (1.0f / sqrtf(__hip_atomic_load(F_ROWSS + t, __ATOMIC_RELAXED, __HIP_MEMORY_SCOPE_AGENT) * (1.0f / DM) + NORM_EPS));
        const float act0 = gelu_exact((a0 - 7.5f * ctot) * ua) * gt0, act1 = gelu_exact((a1 - 7.5f * ctot) * ua) * gt1;
#endif
#define FP4_UNPACK(w, lo0, hi0, lo1, hi1) const h2v lo0 = __builtin_amdgcn_cvt_scalef32_pk_f16_fp4(w, 1.0f, 0), hi0 = __builtin_amdgcn_cvt_scalef32_pk_f16_fp4(w, 1.0f, 1), \
                                                   lo1 = __builtin_amdgcn_cvt_scalef32_pk_f16_fp4(w, 1.0f, 2), hi1 = __builtin_amdgcn_cvt_scalef32_pk_f16_fp4(w, 1.0f, 3)
        h2v acc[2][8][2];
#pragma unroll
        for (int c2 = 0; c2 < 2; ++c2)
#pragma unroll
            for (int j = 0; j < 8; ++j) { acc[c2][j][0] = (h2v){(_Float16)0.f, (_Float16)0.f}; acc[c2][j][1] = (h2v){(_Float16)0.f, (_Float16)0.f}; }
#define P9_ACCG(buf, g) do { _Pragma("unroll") for (int r_ = 0; r_ < 4; ++r_) { const int s_ = 4 * (g) + r_; const _Float16 wt_ = (_Float16)((ACC_SCALE / V_SCALE / P9_VALU_REPS) * __uint_as_float(__builtin_amdgcn_readlane(__float_as_uint(s_ < 64 ? act0 : act1), s_ & 63))); const h2v gg = (h2v){wt_, wt_}; \
                _Pragma("unroll") for (int c2 = 0; c2 < 2; ++c2) _Pragma("unroll") for (int m = 0; m < 4; ++m) { _Pragma("unroll") for (int vd_ = 0; vd_ < P9_VALU_REPS; ++vd_) { unsigned w = buf[r_][c2][m]; if (P9_VALU_REPS > 1) asm volatile("" : "+v"(w)); FP4_UNPACK(w, l0, h0, l1, h1); \
                    acc[c2][2 * m][0] = gg * l0 + acc[c2][2 * m][0]; acc[c2][2 * m][1] = gg * h0 + acc[c2][2 * m][1]; acc[c2][2 * m + 1][0] = gg * l1 + acc[c2][2 * m + 1][0]; acc[c2][2 * m + 1][1] = gg * h1 + acc[c2][2 * m + 1][1]; } } } } while (0)
        for (int vrep_ = 0; vrep_ < (P9_DUP_PART == 2 ? 2 : 1); ++vrep_) {
#pragma unroll
        for (int c2 = 0; c2 < 2; ++c2)
#pragma unroll
            for (int j = 0; j < 8; ++j) { acc[c2][j][0] = (h2v){(_Float16)0.f, (_Float16)0.f}; acc[c2][j][1] = (h2v){(_Float16)0.f, (_Float16)0.f}; }
        { v4u wA[4][2], wB[4][2], wC[4][2];
          P9_LOADG(wA, F_V4, 0); P9_LOADG(wB, F_V4, 1);
#pragma unroll 1
          for (int g = 0; g < 30; g += 3) {
              P9_LOADG(wC, F_V4, g + 2); P9_ACCG(wA, g);
              P9_LOADG(wA, F_V4, g + 3); P9_ACCG(wB, g + 1);
              P9_LOADG(wB, F_V4, g + 4); P9_ACCG(wC, g + 2);
          }
          P9_ACCG(wA, 30); P9_ACCG(wB, 31); } }
#undef FP4_UNPACK
#undef P9_SLOT_E
#undef P9_LOADG
#undef P9_DOTG
#undef P9_ACCG
        float hs[2][8][4]; float ss = 0.f;
#pragma unroll
        for (int c2 = 0; c2 < 2; ++c2)
#pragma unroll
            for (int j = 0; j < 8; ++j) { const v2u hw_ = *(const GAS v2u*)((const bf16*)F_H1 + (size_t)t * DM + c2 * 2048 + j * 256 + lane * 4); const f32x4 hv = {bflo(hw_.x), bfhi(hw_.x), bflo(hw_.y), bfhi(hw_.y)};
                hs[c2][j][0] = hv[0] + (float)acc[c2][j][0].x * (1.0f / ACC_SCALE); hs[c2][j][1] = hv[1] + (float)acc[c2][j][0].y * (1.0f / ACC_SCALE);
                hs[c2][j][2] = hv[2] + (float)acc[c2][j][1].x * (1.0f / ACC_SCALE); hs[c2][j][3] = hv[3] + (float)acc[c2][j][1].y * (1.0f / ACC_SCALE);
#pragma unroll
                for (int q = 0; q < 4; ++q) ss += hs[c2][j][q] * hs[c2][j][q]; }
        const float r = 1.0f / sqrtf(wave_sum(ss) * (1.0f / DM) + NORM_EPS);
#pragma unroll
        for (int c2 = 0; c2 < 2; ++c2)
#pragma unroll
            for (int j = 0; j < 8; ++j) { const f32x4 g = *(const GAS f32x4*)(nfp + c2 * 2048 + j * 256 + lane * 4);
                *(GAS f32x4*)(F.out + (size_t)t * DM + c2 * 2048 + j * 256 + lane * 4) = (f32x4){hs[c2][j][0] * r * g[0], hs[c2][j][1] * r * g[1], hs[c2][j][2] * r * g[2], hs[c2][j][3] * r * g[3]}; }
    }
}

#if PEER_SLICED

constexpr size_t WS_PART = WS_END;
constexpr size_t WS_Y16 = WS_PART + 32 * MiB;
constexpr size_t WS_END2 = WS_Y16 + 64 * MiB;
#define F_PART ((int*)(F.ws + WS_PART))
#define F_Y16 ((_Float16*)(F.ws + WS_Y16))
constexpr size_t SUB_BYTES = (size_t)NEXP * 128;
__device__ __forceinline__ void p0_tables(Frame& F, LAS unsigned* scr) {
    const int gw = F.vcu * NWAVES + F.wave, NGW = F.G * NWAVES, lane = F.lane, odd = lane & 1;
    constexpr int NCH = NEXP * 2;
    for (int cidx = gw; cidx < 2 * NCH; cidx += NGW) {
        const bool isu = cidx < NCH; const int cc = isu ? cidx : cidx - NCH, e = cc >> 1, hh = cc & 1;
        const GAS f32x4* src = (const GAS f32x4*)((isu ? F_IN(13) : F_IN(14)) + (size_t)cc * 2048) + lane;
        f32x4 a[8];
#pragma unroll
        for (int j = 0; j < 8; ++j) a[j] = src[j * 64];
#pragma unroll
        for (int j = 0; j < 8; ++j) { unsigned piece;
            if (isu) { piece = 0u;
#pragma unroll
                for (int q = 0; q < 4; ++q) { int n = (int)floorf(a[j][q] * (1.0f / U_STEP)) + 8; n = n < 0 ? 0 : (n > 15 ? 15 : n); piece |= (unsigned)n << (8 * q); }
                piece <<= 4 * odd;
            } else { unsigned we = 0u, wo = 0u; const float v0 = a[j].x * V_SCALE, v1 = a[j].y * V_SCALE, v2 = a[j].z * V_SCALE, v3 = a[j].w * V_SCALE;
                we = __builtin_amdgcn_cvt_scalef32_pk_fp4_f32(we, v0, v1, 1.0f, 0); we = __builtin_amdgcn_cvt_scalef32_pk_fp4_f32(we, v2, v3, 1.0f, 1);
                wo = __builtin_amdgcn_cvt_scalef32_pk_fp4_f32(wo, v0, v1, 1.0f, 2); wo = __builtin_amdgcn_cvt_scalef32_pk_fp4_f32(wo, v2, v3, 1.0f, 3);
                piece = odd ? wo : we; }
            const unsigned full = piece | (unsigned)__builtin_amdgcn_update_dpp(0, (int)piece, 0xB1, 0xF, 0xF, false);
            if (!odd) scr[j * 32 + (lane >> 1)] = full; }
        LDS_WAIT(); asm volatile("" ::: "memory");
        const v4u o = *(const LAS v4u*)(scr + lane * 4);
        LDS_WAIT(); asm volatile("" ::: "memory");
        unsigned char* dst = (isu ? F_U4 : F_V4) + (size_t)(8 * hh + (lane >> 3)) * SUB_BYTES + (size_t)e * 128 + (lane & 7) * 16;
        *(GAS v4u*)dst = o;
    }
}

__device__ __forceinline__ void p9a_udot(Frame& F) {
    const int R = F.G >> 3, k = F.vcu / R, rank = F.vcu % R, lane = F.lane, wave = F.wave, c = lane & 7, g8 = lane >> 3;
    LAS int* aP = (LAS int*)F.lds;
    for (int tb = rank * 256; tb < M; tb += R * 256) {
        for (int i = F.tid; i < 256 * 128; i += NTHR) aP[i] = 0;
        __syncthreads();
        const int tw = tb + wave * 32;
#define A_TOK(n) (tw + ((n) & 31))
#define A_SUB(n) (2 * k + ((n) >> 5))
#define A_E(n, E0, E1) do { E0 = F_EIDX[(size_t)A_TOK(n) * NSLOT + lane]; E1 = F_EIDX[(size_t)A_TOK(n) * NSLOT + 64 + lane]; } while (0)
#define A_X(n, XA, XB) do { const GAS v4u* xp_ = (const GAS v4u*)(F_HQ8 + (size_t)A_TOK(n) * DM + 256 * A_SUB(n) + 32 * c); XA = xp_[0]; XB = xp_[1]; } while (0)
#define A_G(n, E0, E1, W) do { const unsigned char* tb_ = F_U4 + (size_t)A_SUB(n) * SUB_BYTES + c * 16; \
            _Pragma("unroll") for (int ii = 0; ii < 16; ++ii) { const int el = __shfl(ii < 8 ? E0 : E1, 8 * (ii & 7) + g8); W[ii] = *(const GAS v4u*)(tb_ + (size_t)el * 128); } } while (0)
#define A_C(n, XA, XB, W) do { const int xlo[4] = {(int)XA.x, (int)XA.z, (int)XB.x, (int)XB.z}, xhi[4] = {(int)XA.y, (int)XA.w, (int)XB.y, (int)XB.w}; const int tl_ = wave * 32 + ((n) & 31); \
            _Pragma("unroll") for (int ii = 0; ii < 16; ++ii) { int s_ = 0; \
                _Pragma("unroll") for (int m = 0; m < 4; ++m) { const unsigned wd = W[ii][m]; \
                    s_ = __builtin_amdgcn_sdot4((int)(wd & 0x0F0F0F0Fu), xlo[m], s_, false); s_ = __builtin_amdgcn_sdot4((int)((wd >> 4) & 0x0F0F0F0Fu), xhi[m], s_, false); } \
                s_ = dpp_addi(s_, 0); s_ = dpp_addi(s_, 1); s_ = dpp_addi(s_, 2); \
                if (c == 0) __hip_atomic_fetch_add(aP + tl_ * 128 + 8 * ii + g8, s_, __ATOMIC_RELAXED, __HIP_MEMORY_SCOPE_WORKGROUP); } } while (0)
        int eA0, eA1, eB0, eB1; v4u xA0, xA1, xB0, xB1, wA[16], wB[16];
        A_E(0, eA0, eA1); A_E(1, eB0, eB1); A_G(0, eA0, eA1, wA); A_X(0, xA0, xA1);
#pragma unroll 1
        for (int n = 0; n < 64; n += 2) {
            if (n + 2 < 64) A_E(n + 2, eA0, eA1); A_G(n + 1, eB0, eB1, wB); A_X(n + 1, xB0, xB1);
            A_C(n, xA0, xA1, wA);
            if (n + 3 < 64) A_E(n + 3, eB0, eB1); if (n + 2 < 64) { A_G(n + 2, eA0, eA1, wA); A_X(n + 2, xA0, xA1); }
            A_C(n + 1, xB0, xB1, wB);
        }
#undef A_TOK
#undef A_SUB
#undef A_E
#undef A_X
#undef A_G
#undef A_C
        __syncthreads();
        { GAS v4u* dst = (GAS v4u*)(F_PART + ((size_t)k * M + tb) * NSLOT);
          for (int i = F.tid; i < 256 * 128 / 4; i += NTHR) dst[i] = *(const LAS v4u*)(aP + 4 * i); }
        __syncthreads();
    }
}

__device__ __forceinline__ void p9b_vsum(Frame& F) {
    const int R = F.G >> 3, k = F.vcu / R, rank = F.vcu % R, lane = F.lane, wave = F.wave, c = lane & 7, g8 = lane >> 3;
    LAS _Float16* actL = (LAS _Float16*)F.lds;
    for (int tb = rank * 256; tb < M; tb += R * 256) {
        const int tw = tb + wave * 32;
#pragma unroll 1
        for (int i4 = 0; i4 < 32; i4 += 4) { int s0[4], s1[4]; float sxv[4], g0[4], g1[4]; int csv[4];
#pragma unroll
            for (int u = 0; u < 4; ++u) { const int tok = tw + i4 + u; s0[u] = 0; s1[u] = 0;
#pragma unroll
                for (int kk = 0; kk < 8; ++kk) { s0[u] += F_PART[((size_t)kk * M + tok) * NSLOT + lane]; s1[u] += F_PART[((size_t)kk * M + tok) * NSLOT + 64 + lane]; }
                sxv[u] = (1.0f / HQ_SCALE) / sqrtf(__hip_atomic_load(F_ROWSS + tok, __ATOMIC_RELAXED, __HIP_MEMORY_SCOPE_AGENT) * (1.0f / DM) + NORM_EPS); csv[u] = __hip_atomic_load(F_ROWCS + tok, __ATOMIC_RELAXED, __HIP_MEMORY_SCOPE_AGENT); g0[u] = F_EG[(size_t)tok * NSLOT + lane]; g1[u] = F_EG[(size_t)tok * NSLOT + 64 + lane]; }
#pragma unroll
            for (int u = 0; u < 4; ++u) { const int tl = wave * 32 + i4 + u; const float ua = U_STEP * sxv[u], cb = 7.5f * (float)csv[u];
                const float act0 = gelu_exact(((float)s0[u] - cb) * ua) * g0[u] * (ACC_SCALE / V_SCALE), act1 = gelu_exact(((float)s1[u] - cb) * ua) * g1[u] * (ACC_SCALE / V_SCALE);
                actL[tl * 128 + (lane & 7) * 16 + (lane >> 3)] = (_Float16)act0;
                actL[tl * 128 + (lane & 7) * 16 + 8 + (lane >> 3)] = (_Float16)act1; } }
        LDS_WAIT(); asm volatile("" ::: "memory");
#define B_TOK(n) (tw + ((n) & 31))
#define B_SUB(n) (2 * k + ((n) >> 5))
#define B_E(n, E0, E1) do { E0 = F_EIDX[(size_t)B_TOK(n) * NSLOT + lane]; E1 = F_EIDX[(size_t)B_TOK(n) * NSLOT + 64 + lane]; } while (0)
#define B_YP(n) ((GAS v2u*)(F_Y16 + (size_t)B_TOK(n) * DM + 256 * B_SUB(n) + 32 * c + 4 * g8))
#define B_G(n, E0, E1, W) do { const unsigned char* tb_ = F_V4 + (size_t)B_SUB(n) * SUB_BYTES + c * 16; \
            _Pragma("unroll") for (int ii = 0; ii < 16; ++ii) { const int el = __shfl(ii < 8 ? E0 : E1, 8 * (ii & 7) + g8); W[ii] = *(const GAS v4u*)(tb_ + (size_t)el * 128); } } while (0)
#define B_C(n, W) do { const int tl_ = wave * 32 + ((n) & 31); \
            const v4u wq0 = *(const LAS v4u*)(actL + tl_ * 128 + g8 * 16), wq1 = *(const LAS v4u*)(actL + tl_ * 128 + g8 * 16 + 8); \
            h2v acc[4][4]; \
            _Pragma("unroll") for (int m = 0; m < 4; ++m) _Pragma("unroll") for (int b = 0; b < 4; ++b) acc[m][b] = (h2v){(_Float16)0.f, (_Float16)0.f}; \
            _Pragma("unroll") for (int ii = 0; ii < 16; ++ii) { const unsigned wp = ii < 8 ? wq0[ii >> 1] : wq1[(ii - 8) >> 1]; const h2v wpair = __builtin_bit_cast(h2v, wp); \
                const _Float16 wt = (ii & 1) ? wpair.y : wpair.x; const h2v gg = (h2v){wt, wt}; \
                _Pragma("unroll") for (int m = 0; m < 4; ++m) { const unsigned wd = W[ii][m]; \
                    acc[m][0] = gg * __builtin_amdgcn_cvt_scalef32_pk_f16_fp4(wd, 1.0f, 0) + acc[m][0]; acc[m][1] = gg * __builtin_amdgcn_cvt_scalef32_pk_f16_fp4(wd, 1.0f, 1) + acc[m][1]; \
                    acc[m][2] = gg * __builtin_amdgcn_cvt_scalef32_pk_f16_fp4(wd, 1.0f, 2) + acc[m][2]; acc[m][3] = gg * __builtin_amdgcn_cvt_scalef32_pk_f16_fp4(wd, 1.0f, 3) + acc[m][3]; } } \
            _Pragma("unroll") for (int m = 0; m < 4; ++m) _Pragma("unroll") for (int b = 0; b < 4; ++b) { const int bits = __builtin_bit_cast(int, acc[m][b]); \
                h2v t = acc[m][b] + __builtin_bit_cast(h2v, __builtin_amdgcn_update_dpp(0, bits, 0x128, 0xF, 0xF, false)); \
                t = t + __builtin_bit_cast(h2v, __shfl_xor(__builtin_bit_cast(int, t), 16)); \
                { const unsigned tb2_ = __builtin_bit_cast(unsigned, t); auto rr_ = __builtin_amdgcn_permlane32_swap(tb2_, tb2_, false, false); t = __builtin_bit_cast(h2v, (unsigned)rr_[0]) + __builtin_bit_cast(h2v, (unsigned)rr_[1]); } acc[m][b] = t; } \
            h2v o0 = acc[0][0], o1 = acc[0][1]; \
            _Pragma("unroll") for (int gg8 = 1; gg8 < 8; ++gg8) { if (g8 == gg8) { o0 = acc[gg8 >> 1][2 * (gg8 & 1)]; o1 = acc[gg8 >> 1][2 * (gg8 & 1) + 1]; } } \
            v2u yo_; yo_.x = __builtin_bit_cast(unsigned, o0); yo_.y = __builtin_bit_cast(unsigned, o1); *B_YP(n) = yo_; } while (0)
        int eA0, eA1, eB0, eB1; v4u wA[16], wB[16];
        B_E(0, eA0, eA1); B_E(1, eB0, eB1); B_G(0, eA0, eA1, wA);
#pragma unroll 1
        for (int n = 0; n < 64; n += 2) {
            if (n + 2 < 64) B_E(n + 2, eA0, eA1); B_G(n + 1, eB0, eB1, wB);
            B_C(n, wA);
            if (n + 3 < 64) B_E(n + 3, eB0, eB1); if (n + 2 < 64) B_G(n + 2, eA0, eA1, wA);
            B_C(n + 1, wB);
        }
#undef B_TOK
#undef B_SUB
#undef B_E
#undef B_YP
#undef B_G
#undef B_C
        LDS_WAIT(); asm volatile("" ::: "memory");
    }
}

__device__ __forceinline__ void p9c_final(Frame& F) {
    const int gw = F.vcu * NWAVES + F.wave, NGW = F.G * NWAVES, lane = F.lane;
    for (int m = gw; m < M; m += NGW) {
        const GAS f32x4* xr = (const GAS f32x4*)(F_H1 + (size_t)m * DM) + lane; const GAS f32x4* gr = (const GAS f32x4*)F_IN(15) + lane; GAS f32x4* orow = (GAS f32x4*)(F.out + (size_t)m * DM) + lane; const GAS v2u* yr = (const GAS v2u*)(F_Y16 + (size_t)m * DM) + lane;
        f32x4 v[16]; float s = 0.f;
#pragma unroll
        for (int j = 0; j < 16; ++j) { v[j] = xr[64 * j]; const v2u yw = yr[64 * j]; const unsigned yw0 = yw.x, yw1 = yw.y; const h2v y0 = __builtin_bit_cast(h2v, yw0), y1 = __builtin_bit_cast(h2v, yw1);
            v[j].x += (float)y0.x * (1.0f / ACC_SCALE); v[j].y += (float)y0.y * (1.0f / ACC_SCALE); v[j].z += (float)y1.x * (1.0f / ACC_SCALE); v[j].w += (float)y1.y * (1.0f / ACC_SCALE);
            s += (v[j].x * v[j].x + v[j].y * v[j].y) + (v[j].z * v[j].z + v[j].w * v[j].w); }
        const float r = 1.0f / sqrtf(wave_sum(s) * (1.0f / DM) + NORM_EPS);
#pragma unroll
        for (int j = 0; j < 16; ++j) { const f32x4 g = gr[64 * j]; orow[64 * j] = (f32x4){v[j].x * r * g.x, v[j].y * r * g.y, v[j].z * r * g.z, v[j].w * r * g.w}; }
    }
}

#endif
struct Args { const float* in[16]; float* out; unsigned char* ws; int ph_lo, ph_hi; };
__global__ void __launch_bounds__(NTHR, 2) fwd(Args args) {
    extern __shared__ __attribute__((aligned(16))) unsigned char lds[];
    Frame F;
    F.lds = (LAS unsigned char*)lds;
    F.tid = threadIdx.x; F.lane = F.tid & 63; F.wave = __builtin_amdgcn_readfirstlane(F.tid >> 6);
    F.G = gridDim.x; { const int bx = blockIdx.x; F.vcu = (F.G % 8 == 0) ? (bx % 8) * (F.G / 8) + bx / 8 : bx; }
    unsigned char* ws = args.ws;
    F.out = args.out;
    F.ws = ws;
    for (int u = F.tid; u < (LDS_BYTES - LDSCTL_OFF) / 4; u += NTHR) ((LAS unsigned*)(F.lds + LDSCTL_OFF))[u] = 0u;
    __syncthreads();
    if (F.tid == 0) { volatile LAS unsigned* ip = (volatile LAS unsigned*)(F.lds + LDSCTL_OFF + 128);
        ip[0] = (unsigned)(unsigned long long)args.in[0]; ip[1] = (unsigned)((unsigned long long)args.in[0] >> 32);
        ip[2] = (unsigned)(unsigned long long)args.in[1]; ip[3] = (unsigned)((unsigned long long)args.in[1] >> 32);
        ip[4] = (unsigned)(unsigned long long)args.in[2]; ip[5] = (unsigned)((unsigned long long)args.in[2] >> 32);
        ip[6] = (unsigned)(unsigned long long)args.in[3]; ip[7] = (unsigned)((unsigned long long)args.in[3] >> 32);
        ip[8] = (unsigned)(unsigned long long)args.in[4]; ip[9] = (unsigned)((unsigned long long)args.in[4] >> 32);
        ip[10] = (unsigned)(unsigned long long)args.in[5]; ip[11] = (unsigned)((unsigned long long)args.in[5] >> 32);
        ip[12] = (unsigned)(unsigned long long)args.in[6]; ip[13] = (unsigned)((unsigned long long)args.in[6] >> 32);
        ip[14] = (unsigned)(unsigned long long)args.in[7]; ip[15] = (unsigned)((unsigned long long)args.in[7] >> 32);
        ip[16] = (unsigned)(unsigned long long)args.in[8]; ip[17] = (unsigned)((unsigned long long)args.in[8] >> 32);
        ip[18] = (unsigned)(unsigned long long)args.in[9]; ip[19] = (unsigned)((unsigned long long)args.in[9] >> 32);
        ip[20] = (unsigned)(unsigned long long)args.in[10]; ip[21] = (unsigned)((unsigned long long)args.in[10] >> 32);
        ip[22] = (unsigned)(unsigned long long)args.in[11]; ip[23] = (unsigned)((unsigned long long)args.in[11] >> 32);
        ip[24] = (unsigned)(unsigned long long)args.in[12]; ip[25] = (unsigned)((unsigned long long)args.in[12] >> 32);
        ip[26] = (unsigned)(unsigned long long)args.in[13]; ip[27] = (unsigned)((unsigned long long)args.in[13] >> 32);
        ip[28] = (unsigned)(unsigned long long)args.in[14]; ip[29] = (unsigned)((unsigned long long)args.in[14] >> 32);
        ip[30] = (unsigned)(unsigned long long)args.in[15]; ip[31] = (unsigned)((unsigned long long)args.in[15] >> 32);
    }
    __syncthreads();
    unsigned* barw = (unsigned*)(ws + WS_CTL) + CW_BAR;
    XcdBarrier bar; bar.bar = barw; bar.x = 0; bar.st = nullptr;
    if (N_LAUNCHES == 1) bar = xcd_barrier_post(barw, (volatile LAS unsigned*)(F.lds + LDSCTL_OFF));
    const int lo = args.ph_lo, hi = args.ph_hi;
#define IN(k) (lo <= (k) && (k) < hi)
#define SEAM(k) do { if (IN(k) && IN((k) + 1)) xcd_barrier(bar); } while (0)
    LAS unsigned char* ring = F.lds;

    if (((PHASE_MASK >> 0) & 1) && IN(0)) { for (int rep_ = 0; rep_ < (DUP_PHASE == 0 ? 2 : 1); ++rep_) { p0_prologue(F); } SEAM(0); }
    if (((PHASE_MASK >> 1) & 1) && IN(1)) { for (int rep_ = 0; rep_ < (DUP_PHASE == 1 ? 2 : 1); ++rep_) {
        { pg8::Gemm g{F_HN, F_WT_IN, M, NGATE0, DM}; pg8::StaticOrder S; S.init(M, NGATE0, F.G, (int)blockIdx.x, GDUP(0));
          pg8::EpiSplitBf16 E{F_PROJ, AW, AW, PROJ_TS, SLABS_BF16};
          pg8::gemm_phase<pg8::EpiSplitBf16, pg8::StaticOrder, true, true>(ring, g, S, E); }
        { pg8::Gemm g{(const bf16*)F_HN8, (const bf16*)F_W8T, M, NPROJ - NGATE0, DM / 2}; pg8::StaticOrder S; S.init(M, NPROJ - NGATE0, F.G, (int)blockIdx.x, GDUP(1));
          pg8::EpiI8Split E{F_PROJ, AW, AW, PROJ_TS, F_SX, 1.0f / W8_SCALE, SLABS_I8};
          pg8::gemm_phase<pg8::EpiI8Split, pg8::StaticOrder, true, true, true>(ring, g, S, E); }
        } SEAM(1);
    }
    if (((PHASE_MASK >> 2) & 1) && IN(2)) { for (int rep_ = 0; rep_ < (DUP_PHASE == 2 ? 2 : 1); ++rep_) { p2_kmean_conv(F); } SEAM(2); }
    if (((PHASE_MASK >> 3) & 1) && IN(3)) { for (int rep_ = 0; rep_ < (DUP_PHASE == 3 ? 2 : 1); ++rep_) { p3_attention(F, (char*)lds); } SEAM(3); }
    if (((PHASE_MASK >> 4) & 1) && IN(4)) { for (int rep_ = 0; rep_ < (DUP_PHASE == 4 ? 2 : 1); ++rep_) {
        { pg8::Gemm g{F_ATT, F_WT_BRA, M, DM, AW / 2}; pg8::StaticOrder S; S.init(M, DM, F.G, (int)blockIdx.x, GDUP(2));
          pg8::EpiGate<false, true> E{F_MRG, DM, F_PROJ + 6 * PROJ_TS, AW, PROJ_TS, F_IN(7), 1.0f / (moba::ATT_SCALE * WB8_SCALE)};
          pg8::gemm_phase<pg8::EpiGate<false, true>, pg8::StaticOrder, true, true, true>(ring, g, S, E); }
        VM_WAIT(); __builtin_amdgcn_fence(__ATOMIC_ACQUIRE, "agent"); VM_WAIT(); __syncthreads();
        { pg8::Gemm g{F_CONV, F_WT_BRC, M, DM, AW}; pg8::StaticOrder S; S.init(M, DM, F.G, (int)blockIdx.x);
          pg8::EpiGate<true> E{F_MRG, DM, F_PROJ + 8 * PROJ_TS, AW, PROJ_TS, F_IN(7) + DM};
          pg8::gemm_phase<pg8::EpiGate<true>, pg8::StaticOrder, true, true>(ring, g, S, E); }
        } SEAM(4);
    }
    if (((PHASE_MASK >> 5) & 1) && IN(5)) { for (int rep_ = 0; rep_ < (DUP_PHASE == 5 ? 2 : 1); ++rep_) {
        pg8::Gemm g{F_MRG, F_WT_OUT, M, DM, DM}; pg8::StaticOrder S; S.init(M, DM, F.G, (int)blockIdx.x);
        pg8::EpiResNormStat E{F_H1, F_IN(0), DM, F_HQ8, F_IN(10), F_ROWSS, HQ_SCALE, PEER_SLICED ? F_ROWCS : nullptr};
        pg8::gemm_phase<pg8::EpiResNormStat, pg8::StaticOrder, true, true>(ring, g, S, E);
        } SEAM(5);
    }
    if (((PHASE_MASK >> 7) & 1) && IN(7)) { for (int rep_ = 0; rep_ < (DUP_PHASE == 7 ? 2 : 1); ++rep_) {
        pg8::Gemm g{(const bf16*)F_HQ8, (const bf16*)F_WPQ8, M, PQW, DM / 2}; pg8::StaticOrder S; S.init(M, PQW, F.G, (int)blockIdx.x, GDUP(4));
        pg8::EpiHiLoI8 E{F_QH, nullptr, PQW, F_ROWSS, 1.0f / DM, NORM_EPS, 1.0f / (HQ_SCALE * W8_SCALE)};
        pg8::gemm_phase<pg8::EpiHiLoI8, pg8::StaticOrder, true, true, true>(ring, g, S, E);
        } SEAM(7);
    }
    if (((PHASE_MASK >> 8) & 1) && IN(8)) { for (int rep_ = 0; rep_ < (DUP_PHASE == 8 ? 2 : 1); ++rep_) { p8_peer_topk(F); } SEAM(8); }
#if PEER_SLICED
    if (((PHASE_MASK >> 9) & 1) && IN(9)) { for (int rep_ = 0; rep_ < (DUP_PHASE == 9 ? 2 : 1); ++rep_) { p9a_udot(F); } SEAM(9); }
    if (((PHASE_MASK >> 10) & 1) && IN(10)) { for (int rep_ = 0; rep_ < (DUP_PHASE == 10 ? 2 : 1); ++rep_) { p9b_vsum(F); } SEAM(10); }
    if (((PHASE_MASK >> 11) & 1) && IN(11)) { for (int rep_ = 0; rep_ < (DUP_PHASE == 11 ? 2 : 1); ++rep_) { p9c_final(F); } }
#else
    if (((PHASE_MASK >> 9) & 1) && IN(9)) { for (int rep_ = 0; rep_ < (DUP_PHASE == 9 ? 2 : 1); ++rep_) { p9_peer_final(F); } }
#endif
#undef IN
#undef SEAM
}

extern "C" void kernel_launch(void* const* d_in, const int* in_sizes, int n_in, void* d_out, int out_size, void* d_ws, size_t ws_size, hipStream_t stream) {
    static int grid = 0;
    if (grid == 0) {
        if (n_in != 16 || in_sizes[0] != M * DM || out_size != M * DM || ws_size < WS_END + (PEER_SLICED ? 96 * MiB : 0)) { fprintf(stderr, "kernel_launch: unexpected shapes (n_in %d, in0 %d, out %d, ws %zu < %zu)\n", n_in, n_in > 0 ? in_sizes[0] : -1, out_size, ws_size, (size_t)WS_END); grid = -1; return; }
        int dev = 0, cus = 0, per_cu = 0;
        if (hipGetDevice(&dev) != hipSuccess || hipDeviceGetAttribute(&cus, hipDeviceAttributeMultiprocessorCount, dev) != hipSuccess) { grid = -1; return; }
        if (hipFuncSetAttribute((const void*)fwd, hipFuncAttributeMaxDynamicSharedMemorySize, LDS_BYTES) != hipSuccess) { fprintf(stderr, "kernel_launch: hipFuncSetAttribute failed\n"); grid = -1; return; }
        if (hipOccupancyMaxActiveBlocksPerMultiprocessor(&per_cu, (const void*)fwd, NTHR, LDS_BYTES) != hipSuccess || per_cu < 1) { fprintf(stderr, "kernel_launch: occupancy query says %d blocks per CU\n", per_cu); }
        (void)hipGetLastError();
        grid = cus;
    }
    if (grid < 0) return;
    if (hipMemsetAsync((char*)d_ws + WS_CTL, 0, CTL_ZERO_BYTES, stream) != hipSuccess) return;
    Args a{};
    for (int i = 0; i < 16; ++i) a.in[i] = (const float*)d_in[i];
    a.out = (float*)d_out; a.ws = (unsigned char*)d_ws;
    for (int li = 0; li < N_LAUNCHES; ++li) {
        a.ph_lo = (N_LAUNCHES == 1) ? 0 : li; a.ph_hi = (N_LAUNCHES == 1) ? N_PHASES : li + 1;
        hipLaunchKernelGGL(fwd, dim3(grid), dim3(NTHR), LDS_BYTES, stream, a);
        if (hipPeekAtLastError() != hipSuccess) { fprintf(stderr, "kernel_launch: launch %d failed\n", li); break; }
    }
}
```
